# Optimizing an MI355X kernel written in HIP

```python
import jax, jax.numpy as jnp
from jax import lax
import numpy as np

D_MODEL = 2048
BATCH = 2
SEQ = 8192
DEPTH = 1

CHUNK = 64
Q_BLOCK = 128
EPS = 1e-6

CONV_WIDTH = 1024
CONV_K = 3

MLA_HEADS = 16
Q_LORA = 512
KV_LORA = 512
QK_NOPE = 128
QK_ROPE = 64
V_HEAD = 128
MLA_WIDTH = MLA_HEADS * V_HEAD
ROPE_THETA = 10000.0

MEM_TOKENS = 256
MEM_HEADS = 4
MEM_HEAD_DIM = 256
MEM_WIDTH = MEM_HEADS * MEM_HEAD_DIM

IN_SPLITS = (
    CONV_WIDTH, CONV_WIDTH, CONV_WIDTH, CONV_WIDTH,
    Q_LORA, KV_LORA, QK_ROPE, MLA_WIDTH,
    MEM_WIDTH, MEM_WIDTH,
    D_MODEL, D_MODEL, D_MODEL,
)
IN_WIDTH = sum(IN_SPLITS)

kernel_name = "hybrid_conv_mla_memory_block"


def rms_norm(x, g):
    xf = x.astype(jnp.float32)
    y = xf * lax.rsqrt(jnp.mean(xf * xf, axis=-1, keepdims=True) + EPS)
    return (y * g.astype(jnp.float32)).astype(x.dtype)


def apply_rope(x, cos, sin):
    x1, x2 = jnp.split(x.astype(jnp.float32), 2, axis=-1)
    return jnp.concatenate([x1 * cos - x2 * sin, x2 * cos + x1 * sin], axis=-1).astype(x.dtype)


def causal_depthwise_conv(u, w):
    k, c = w.shape
    return lax.conv_general_dilated(
        u, w[:, None, :].astype(u.dtype), window_strides=(1,), padding=[(k - 1, 0)],
        dimension_numbers=("NWC", "WIO", "NWC"), feature_group_count=c)


def mla_attention(c_q, c_kv, k_rope_raw, cos, sin, q_norm_g, w_uq, kv_norm_g, w_ukv,
                  qn_nope_g, qn_rope_g, kn_nope_g, kn_rope_g):
    b, s, _ = c_q.shape
    q = (rms_norm(c_q, q_norm_g) @ w_uq).reshape(b, s, MLA_HEADS, QK_NOPE + QK_ROPE)
    q_nope = rms_norm(q[..., :QK_NOPE], qn_nope_g)
    q_rope = apply_rope(rms_norm(q[..., QK_NOPE:], qn_rope_g), cos[:, :, None], sin[:, :, None])
    kv = (rms_norm(c_kv, kv_norm_g) @ w_ukv).reshape(b, s, MLA_HEADS, QK_NOPE + V_HEAD)
    k_nope = rms_norm(kv[..., :QK_NOPE], kn_nope_g)
    v = kv[..., QK_NOPE:]
    k_rope = apply_rope(rms_norm(k_rope_raw, kn_rope_g), cos, sin)
    scale = (QK_NOPE + QK_ROPE) ** -0.5
    n_blk = s // Q_BLOCK
    qn_blocks = q_nope.reshape(b, n_blk, Q_BLOCK, MLA_HEADS, QK_NOPE).transpose(1, 0, 2, 3, 4)
    qr_blocks = q_rope.reshape(b, n_blk, Q_BLOCK, MLA_HEADS, QK_ROPE).transpose(1, 0, 2, 3, 4)
    k_chunk = jnp.arange(s) // CHUNK

    def attend(args):
        qn, qr, blk = args
        sc = (jnp.einsum("bqhd,bkhd->bhqk", qn, k_nope, preferred_element_type=jnp.float32)
              + jnp.einsum("bqhr,bkr->bhqk", qr, k_rope, preferred_element_type=jnp.float32))
        q_chunk = (blk * Q_BLOCK + jnp.arange(Q_BLOCK)) // CHUNK
        allowed = k_chunk[None, :] <= q_chunk[:, None]
        p = jax.nn.softmax(jnp.where(allowed, sc * scale, -jnp.inf), axis=-1)
        return jnp.einsum("bhqk,bkhd->bqhd", p.astype(v.dtype), v)

    o = lax.map(attend, (qn_blocks, qr_blocks, jnp.arange(n_blk)))
    return o.transpose(1, 0, 2, 3, 4).reshape(b, s, MLA_WIDTH)


def memory_attention(q_raw, mem, mem_norm_g, w_mem_kv, qn_g, kn_g):
    b, s, _ = q_raw.shape
    m = mem.shape[1]
    q = rms_norm(q_raw.reshape(b, s, MEM_HEADS, MEM_HEAD_DIM), qn_g)
    k, v = jnp.split(rms_norm(mem, mem_norm_g) @ w_mem_kv, 2, axis=-1)
    k = rms_norm(k.reshape(b, m, MEM_HEADS, MEM_HEAD_DIM), kn_g)
    v = v.reshape(b, m, MEM_HEADS, MEM_HEAD_DIM)
    sc = jnp.einsum("bqhd,bmhd->bhqm", q, k, preferred_element_type=jnp.float32) * (MEM_HEAD_DIM ** -0.5)
    p = jax.nn.softmax(sc, axis=-1)
    return jnp.einsum("bhqm,bmhd->bqhd", p.astype(v.dtype), v).reshape(b, s, MEM_WIDTH)


def setup_inputs(seed: int = 0) -> dict:
    key = jax.random.key(seed)
    ks = jax.random.split(key, 24)
    f32 = jnp.float32

    def w(k, shape, fan_in):
        return jax.random.normal(k, shape, f32) * (fan_in ** -0.5)

    def gain(k, shape):
        return 1.0 + 0.02 * jax.random.normal(k, shape, f32)

    x = jax.random.normal(ks[0], (BATCH, SEQ, D_MODEL), f32)
    offsets = jax.random.randint(ks[1], (BATCH, 1), 0, 64, dtype=jnp.int32) * CHUNK
    positions = (offsets + jnp.arange(SEQ, dtype=jnp.int32)[None, :]).astype(jnp.int32)
    mem = jax.random.normal(ks[2], (BATCH, MEM_TOKENS, D_MODEL), f32)
    L = DEPTH
    return {
        "x": x,
        "positions": positions,
        "mem": mem,
        "norm_g": gain(ks[3], (L, D_MODEL)),
        "w_in": w(ks[4], (L, D_MODEL, IN_WIDTH), D_MODEL),
        "conv_w": w(ks[5], (L, CONV_K, CONV_WIDTH), CONV_K),
        "w_conv_out": w(ks[6], (L, CONV_WIDTH, D_MODEL), CONV_WIDTH),
        "mla_q_norm_g": gain(ks[7], (L, Q_LORA)),
        "w_uq": w(ks[8], (L, Q_LORA, MLA_HEADS * (QK_NOPE + QK_ROPE)), Q_LORA),
        "mla_kv_norm_g": gain(ks[9], (L, KV_LORA)),
        "w_ukv": w(ks[10], (L, KV_LORA, MLA_HEADS * (QK_NOPE + V_HEAD)), KV_LORA),
        "mla_qn_nope_g": gain(ks[11], (L, QK_NOPE)),
        "mla_qn_rope_g": gain(ks[12], (L, QK_ROPE)),
        "mla_kn_nope_g": gain(ks[13], (L, QK_NOPE)),
        "mla_kn_rope_g": gain(ks[14], (L, QK_ROPE)),
        "w_mla_out": w(ks[15], (L, MLA_WIDTH, D_MODEL), MLA_WIDTH),
        "mem_norm_g": gain(ks[16], (L, D_MODEL)),
        "w_mem_kv": w(ks[17], (L, D_MODEL, 2 * MEM_WIDTH), D_MODEL),
        "mem_qn_g": gain(ks[18], (L, MEM_HEAD_DIM)),
        "mem_kn_g": gain(ks[19], (L, MEM_HEAD_DIM)),
        "w_mem_out": w(ks[20], (L, MEM_WIDTH, D_MODEL), MEM_WIDTH),
        "w_o": w(ks[21], (L, D_MODEL, D_MODEL), D_MODEL),
    }


def reference(x, positions, mem, norm_g, w_in, conv_w, w_conv_out, mla_q_norm_g, w_uq,
              mla_kv_norm_g, w_ukv, mla_qn_nope_g, mla_qn_rope_g, mla_kn_nope_g, mla_kn_rope_g,
              w_mla_out, mem_norm_g, w_mem_kv, mem_qn_g, mem_kn_g, w_mem_out, w_o):
    half = QK_ROPE // 2
    inv_freq = jnp.power(ROPE_THETA, -jnp.arange(half, dtype=jnp.float32) / half)
    ang = positions.astype(jnp.float32)[..., None] * inv_freq
    cos, sin = jnp.cos(ang), jnp.sin(ang)
    split_at = np.cumsum(IN_SPLITS)[:-1].tolist()

    for l in range(DEPTH):
        h = rms_norm(x, norm_g[l])
        proj = h @ w_in[l]
        (c_gate, b_gate, u, conv_z, c_q, c_kv, k_rope_raw, mla_z,
         mem_q, mem_z, g_conv, g_mla, g_mem) = jnp.split(proj, split_at, axis=-1)

        conv_y = b_gate * causal_depthwise_conv(c_gate * u, conv_w[l])
        o_conv = (conv_y * jax.nn.silu(conv_z)) @ w_conv_out[l]

        mla_y = mla_attention(c_q, c_kv, k_rope_raw, cos, sin, mla_q_norm_g[l], w_uq[l],
                              mla_kv_norm_g[l], w_ukv[l], mla_qn_nope_g[l], mla_qn_rope_g[l],
                              mla_kn_nope_g[l], mla_kn_rope_g[l])
        o_mla = (mla_y * jax.nn.silu(mla_z)) @ w_mla_out[l]

        mem_y = memory_attention(mem_q, mem, mem_norm_g[l], w_mem_kv[l], mem_qn_g[l], mem_kn_g[l])
        o_mem = (mem_y * jax.nn.silu(mem_z)) @ w_mem_out[l]

        merged = (jax.nn.sigmoid(g_conv) * o_conv + jax.nn.sigmoid(g_mla) * o_mla
                  + jax.nn.sigmoid(g_mem) * o_mem)
        x = x + merged @ w_o[l]
    return x
```

```cpp
#include <hip/hip_runtime.h>
#include <hip/hip_cooperative_groups.h>
#include <cstdio>
#include <cstdint>
namespace cg = cooperative_groups;
namespace pg8 {
#define PG8_LAS __attribute__((address_space(3)))
typedef unsigned short bf16_t;
typedef short bf16x8 __attribute__((ext_vector_type(8)));
typedef float f32x4 __attribute__((ext_vector_type(4)));
typedef unsigned u32x4 __attribute__((ext_vector_type(4)));
constexpr int BM = 256, BK = 64, HALF = 128, HTB = HALF * BK * 2  , STAGE_BYTES = 8 * HTB, NXCD = 8, WGM = 8;

__host__ __device__ __forceinline__ int lds_byte(int r, int c) { const int st = (r >> 4) * 2 + (c >> 5), rr = r & 15, cc = c & 31, ob = rr * 64 + cc * 2; return st * 1024 + (ob ^ (((ob >> 9) & 1) << 5)); }
__host__ __device__ __forceinline__ void stage_rc(int b, int& R, int& C) { const int st = b / 1024, sb = b % 1024, swz = sb ^ (((sb >> 9) & 1) << 5); R = (st >> 1) * 16 + swz / 64; C = (st & 1) * 32 + (swz % 64) / 2; }
__host__ __device__ __forceinline__ int perm32(int rho) { const int n = rho >> 4, i = rho & 15; return 8 * (i >> 2) + 4 * n + (i & 3); }

struct Unit { int pm, pn, job; };
struct Gemm { const bf16_t* A; const bf16_t* Bt; int M, N, K; const bf16_t* A2 = nullptr; const bf16_t* Bt2 = nullptr; };

struct StaticOrder {
    int nM, nN, nwg, G, c;
    __host__ __device__ void init(int M, int N, int G_, int c_) { nM = M / BM; nN = N / BM; nwg = nM * nN; G = G_; c = c_; }
    __host__ __device__ bool next(int i, Unit& u) const { const long L = (long)i * G + c; if (L >= nwg) return false; map((int)L, u); u.job = 0; return true; }
    __host__ __device__ void map(int wgid, Unit& u) const {
        { const int q = nwg / NXCD, r = nwg % NXCD, xcd = wgid % NXCD, off = wgid / NXCD; wgid = (xcd < r ? xcd * (q + 1) : r * (q + 1) + (xcd - r) * q) + off; }
        const int nig = WGM * nN, gid = wgid / nig, fm = gid * WGM, gsz = (nM - fm) < WGM ? (nM - fm) : WGM;
        u.pm = fm + ((wgid % nig) % gsz); u.pn = (wgid % nig) / gsz;
    }
    __device__ __forceinline__ void a_ready(const Unit&) const {}
    __device__ __forceinline__ void done(const Unit&) const {}
};

struct DualOrder {
    StaticOrder a, b;
    __host__ __device__ bool next(int i, Unit& u) const { const long L = (long)i * a.G + a.c; if (L < a.nwg) { a.map((int)L, u); u.job = 0; return true; } if (L - a.nwg >= b.nwg) return false; b.map((int)(L - a.nwg), u); u.job = 1; return true; }
    __device__ __forceinline__ void a_ready(const Unit&) const {}
    __device__ __forceinline__ void done(const Unit&) const {}
};

__device__ __forceinline__ unsigned cvt_pk_bf16(float lo, float hi) { unsigned r; asm volatile("v_cvt_pk_bf16_f32 %0, %1, %2" : "=v"(r) : "v"(lo), "v"(hi)); return r; }
template <class Epi, class Sched, bool ALIGN_EPI = false, bool SP2 = false>
__device__ __forceinline__ void gemm_phase(PG8_LAS unsigned char* lds, const Gemm g, const Sched& S, const Epi& E, const int wid0) {
    int tid_l; asm volatile("v_mbcnt_lo_u32_b32 %0, -1, 0\n\tv_mbcnt_hi_u32_b32 %0, -1, %0" : "=v"(tid_l)); tid_l += wid0 * 64;
    const int tid = tid_l, wid = __builtin_amdgcn_readfirstlane(tid >> 6), lane = tid & 63, wr = wid >> 2, wc = wid & 3, fr = lane & 15, fq = lane >> 4;
    const int K = g.K, nt = K / BK;
    unsigned voffA[2], voffB[2];
#pragma unroll
    for (int i = 0; i < 2; ++i) { int R, C; stage_rc(tid * 16 + i * 8192, R, C); const int Rb = Epi::PERM ? ((R & ~31) + perm32(R & 31)) : R;
        voffA[i] = (unsigned)(R * K + C) * 2u; voffB[i] = (unsigned)(Rb * K + C) * 2u; }
    const size_t kstep = (size_t)(BK * 2);
    const size_t hstep = (size_t)HALF * K * 2;
    const size_t tstep = 2 * hstep;
    const unsigned ldsw = (unsigned)wid * 1024u;
    const int aoff = lds_byte(wr * 64 + fr, fq * 8), boff = lds_byte(wc * 32 + fr, fq * 8);
#define PG8_SA(b, h) (((b) * 2 + (h)) * HTB)
#define PG8_SB(b, h) ((4 + (b) * 2 + (h)) * HTB)
#define PG8_STAGE(bufoff, gbase, voff) do { _Pragma("unroll") for (int _i = 0; _i < 2; ++_i) \
        __builtin_amdgcn_global_load_lds((const unsigned*)((const char*)(gbase) + (voff)[_i]), (PG8_LAS unsigned*)(lds + (bufoff) + ldsw + _i * 8192), 16, 0, 0); } while (0)
#define PG8_LDA(dst, b, h) do { _Pragma("unroll") for (int m = 0; m < 4; ++m) _Pragma("unroll") for (int k = 0; k < 2; ++k) dst[m][k] = *(const PG8_LAS bf16x8*)(lds + PG8_SA(b, h) + aoff + m * 2048 + k * 1024); } while (0)
#define PG8_LDB(dst, b, h) do { _Pragma("unroll") for (int n = 0; n < 2; ++n) _Pragma("unroll") for (int k = 0; k < 2; ++k) dst[n][k] = *(const PG8_LAS bf16x8*)(lds + PG8_SB(b, h) + boff + n * 2048 + k * 1024); } while (0)
#define PG8_MMA(ai, bj, At, Bt) do { __builtin_amdgcn_s_setprio(1); _Pragma("unroll") for (int m = 0; m < 4; ++m) _Pragma("unroll") for (int n = 0; n < 2; ++n) _Pragma("unroll") for (int k = 0; k < 2; ++k) \
        acc[ai][bj][m][n] = __builtin_amdgcn_mfma_f32_16x16x32_bf16(Bt[n][k], At[m][k], acc[ai][bj][m][n], 0, 0, 0); __builtin_amdgcn_s_setprio(0); } while (0)
#define PG8_WAIT_V(n) asm volatile("s_waitcnt vmcnt(" #n ")" ::: "memory")
#define PG8_WAIT_L(n) asm volatile("s_waitcnt lgkmcnt(" #n ")" ::: "memory")
#define PG8_BAR __builtin_amdgcn_s_barrier()
#define PG8_SCHED __builtin_amdgcn_sched_barrier(0)
    Unit cur, nxt; int ui = 0;
    if (!S.next(0, cur)) return;
    f32x4 acc[2][2][4][2];
#pragma unroll
    for (int a = 0; a < 2; ++a)
#pragma unroll
        for (int b = 0; b < 2; ++b)
#pragma unroll
            for (int m = 0; m < 4; ++m)
#pragma unroll
                for (int n = 0; n < 2; ++n) acc[a][b][m][n] = (f32x4){0.f, 0.f, 0.f, 0.f};
    bf16x8 At[4][2], B0[2][2], B1[2][2];
    const char* cA = (const char*)(cur.job ? g.A2 : g.A) + (size_t)cur.pm * tstep; const char* cB = (const char*)(cur.job ? g.Bt2 : g.Bt) + (size_t)cur.pn * tstep;
    S.a_ready(cur);
    if constexpr (SP2) {
        PG8_STAGE(PG8_SB(0, 0), cB, voffB); PG8_STAGE(PG8_SB(0, 1), cB + hstep, voffB); PG8_STAGE(PG8_SA(0, 0), cA, voffA); PG8_STAGE(PG8_SA(0, 1), cA + hstep, voffA);
        if (wr == 1) PG8_BAR;
        PG8_WAIT_V(2); PG8_BAR;
        PG8_STAGE(PG8_SB(1, 0), cB + kstep, voffB); PG8_STAGE(PG8_SA(1, 0), cA + kstep, voffA); PG8_STAGE(PG8_SB(1, 1), cB + hstep + kstep, voffB);
        PG8_WAIT_V(6); PG8_BAR;
    } else {
        PG8_STAGE(PG8_SB(0, 0), cB, voffB); PG8_STAGE(PG8_SA(0, 0), cA, voffA); PG8_STAGE(PG8_SB(0, 1), cB + hstep, voffB); PG8_STAGE(PG8_SA(0, 1), cA + hstep, voffA);
        if (wr == 1) PG8_BAR;
        PG8_WAIT_V(4); PG8_BAR;
        PG8_STAGE(PG8_SB(1, 0), cB + kstep, voffB); PG8_STAGE(PG8_SA(1, 0), cA + kstep, voffA); PG8_STAGE(PG8_SB(1, 1), cB + hstep + kstep, voffB);
        PG8_WAIT_V(6); PG8_BAR;
    }
    for (;;) {
        const bool has_next = S.next(ui + 1, nxt);
        const char* nA = has_next ? (const char*)(nxt.job ? g.A2 : g.A) + (size_t)nxt.pm * tstep : cA; const char* nB = has_next ? (const char*)(nxt.job ? g.Bt2 : g.Bt) + (size_t)nxt.pn * tstep : cB;
        for (int t = 0; t < nt; t += 2) {
            const bool last = (t == nt - 2);
            const char* a1 = cA + (size_t)(t + 1) * kstep;
            const char* a2 = last ? nA : cA + (size_t)(t + 2) * kstep; const char* b2 = last ? nB : cB + (size_t)(t + 2) * kstep;
            const char* a3 = a2 + kstep; const char* b3 = b2 + kstep;
            if (last && has_next) S.a_ready(nxt);
            if constexpr (SP2) {
            PG8_LDB(B0, 0, 0); PG8_LDB(B1, 0, 1); PG8_SCHED; PG8_LDA(At, 0, 0); PG8_STAGE(PG8_SA(1, 1), a1 + hstep, voffA);
            PG8_WAIT_V(8); PG8_WAIT_L(0); PG8_BAR; PG8_MMA(0, 0, At, B0); PG8_MMA(0, 1, At, B1); PG8_BAR; PG8_SCHED;
            PG8_LDA(At, 0, 1); PG8_STAGE(PG8_SB(0, 0), b2, voffB); PG8_STAGE(PG8_SB(0, 1), b2 + hstep, voffB); PG8_STAGE(PG8_SA(0, 0), a2, voffA);
            PG8_WAIT_V(8); PG8_WAIT_L(0); PG8_BAR; PG8_MMA(1, 0, At, B0); PG8_MMA(1, 1, At, B1); PG8_BAR; PG8_SCHED;
            PG8_LDB(B0, 1, 0); PG8_LDB(B1, 1, 1); PG8_SCHED; PG8_LDA(At, 1, 0); PG8_STAGE(PG8_SA(0, 1), a2 + hstep, voffA);
            PG8_WAIT_V(8); PG8_WAIT_L(0); PG8_BAR; PG8_MMA(0, 0, At, B0); PG8_MMA(0, 1, At, B1); PG8_BAR; PG8_SCHED;
            PG8_LDA(At, 1, 1); PG8_STAGE(PG8_SB(1, 0), b3, voffB); PG8_STAGE(PG8_SB(1, 1), b3 + hstep, voffB); PG8_STAGE(PG8_SA(1, 0), a3, voffA);
            PG8_WAIT_V(8); PG8_WAIT_L(0); PG8_BAR; PG8_MMA(1, 0, At, B0); PG8_MMA(1, 1, At, B1); PG8_BAR; PG8_SCHED;
            } else {
            PG8_LDB(B0, 0, 0); PG8_SCHED; PG8_LDA(At, 0, 0); PG8_STAGE(PG8_SA(1, 1), a1 + hstep, voffA);
            PG8_WAIT_L(8); PG8_BAR; PG8_WAIT_L(0); PG8_MMA(0, 0, At, B0); PG8_BAR; PG8_SCHED;
            PG8_LDB(B1, 0, 1); PG8_STAGE(PG8_SB(0, 0), b2, voffB);
            PG8_BAR; PG8_WAIT_L(0); PG8_MMA(0, 1, At, B1); PG8_BAR;
            PG8_LDA(At, 0, 1); PG8_STAGE(PG8_SA(0, 0), a2, voffA);
            PG8_BAR; PG8_WAIT_L(0); PG8_MMA(1, 0, At, B0); PG8_BAR; PG8_SCHED;
            PG8_STAGE(PG8_SB(0, 1), b2 + hstep, voffB);
            PG8_WAIT_V(6); PG8_BAR; PG8_MMA(1, 1, At, B1); PG8_BAR;
            PG8_LDB(B0, 1, 0); PG8_SCHED; PG8_LDA(At, 1, 0); PG8_STAGE(PG8_SA(0, 1), a2 + hstep, voffA);
            PG8_WAIT_L(8); PG8_BAR; PG8_WAIT_L(0); PG8_MMA(0, 0, At, B0); PG8_BAR; PG8_SCHED;
            PG8_LDB(B1, 1, 1); PG8_STAGE(PG8_SB(1, 0), b3, voffB);
            PG8_BAR; PG8_WAIT_L(0); PG8_MMA(0, 1, At, B1); PG8_BAR;
            PG8_LDA(At, 1, 1); PG8_STAGE(PG8_SA(1, 0), a3, voffA);
            PG8_BAR; PG8_WAIT_L(0); PG8_MMA(1, 0, At, B0); PG8_BAR; PG8_SCHED;
            PG8_STAGE(PG8_SB(1, 1), b3 + hstep, voffB);
            PG8_WAIT_V(6); PG8_BAR; PG8_MMA(1, 1, At, B1); PG8_BAR;
            }
        }
        if constexpr (ALIGN_EPI) { if (wr == 0) PG8_BAR; }
        asm volatile("s_nop 15\n\ts_nop 3" ::: "memory");
        if constexpr (!Epi::AFTER_DRAIN) { E(acc, cur, wr, wc, fr, fq); S.done(cur); }
        if (!has_next) break;
#pragma unroll
        for (int a = 0; a < 2; ++a)
#pragma unroll
            for (int b = 0; b < 2; ++b)
#pragma unroll
                for (int m = 0; m < 4; ++m)
#pragma unroll
                    for (int n = 0; n < 2; ++n) acc[a][b][m][n] = (f32x4){0.f, 0.f, 0.f, 0.f};
        cur = nxt; cA = nA; cB = nB; ++ui;
        if constexpr (ALIGN_EPI) { if (wr == 1) PG8_BAR; }
    }
    PG8_WAIT_V(0);
    if constexpr (!ALIGN_EPI) { if (wr == 0) PG8_BAR; }
    PG8_BAR;
    if constexpr (Epi::AFTER_DRAIN) { E.fused(acc, cur, wr, wc, fr, fq, lds, wid, lane); S.done(cur); }
#undef PG8_SA
#undef PG8_SB
#undef PG8_STAGE
#undef PG8_LDA
#undef PG8_LDB
#undef PG8_MMA
#undef PG8_WAIT_V
#undef PG8_WAIT_L
#undef PG8_BAR
#undef PG8_SCHED
}
}

#define LAS __attribute__((address_space(3)))
typedef unsigned short bf16_t;
typedef short bf16x8 __attribute__((ext_vector_type(8)));
typedef float f32x4 __attribute__((ext_vector_type(4)));
typedef float f32x16 __attribute__((ext_vector_type(16)));
typedef unsigned u32x4 __attribute__((ext_vector_type(4)));
typedef unsigned u32x2 __attribute__((ext_vector_type(2)));

constexpr int TB = 8192, NBATCH = 2, DM = 2048, NIN = 15616, NIN_SRC = 15424, NTHR = 512;
constexpr float EPS = 1e-6f, LOG2E = 1.4426950408889634f;
constexpr size_t MiB = 1u << 20;
constexpr size_t WS_WT_IN = 0, WS_WT_CONV = 61 * MiB, WS_WT_UQ = 65 * MiB, WS_WT_UKV = 68 * MiB, WS_WT_MLAO = 72 * MiB, WS_WT_MEMKV = 80 * MiB, WS_WT_MEMO = 88 * MiB, WS_WT_O = 92 * MiB;
constexpr size_t WS_COS = 100 * MiB, WS_SIN = 102 * MiB, WS_MEMN = 104 * MiB, WS_MEMKV = 106 * MiB, WS_VTM = 108 * MiB, WS_KR = 110 * MiB, WS_KROPE = 112 * MiB, WS_SSQ = 113 * MiB;
constexpr size_t WS_H = 114 * MiB;
constexpr size_t WS_CU = 178 * MiB, WS_BZ = 194 * MiB, WS_CQ = 210 * MiB, WS_CKV = 218 * MiB, WS_VT = 466 * MiB;
constexpr size_t WS_MEMQ = 226 * MiB, WS_MEMZS = 242 * MiB;
constexpr size_t WS_MLAZS = 258 * MiB, WS_GATES = 290 * MiB, WS_QRAW = 386 * MiB, WS_MERGED = 386 * MiB  ;
constexpr size_t WS_CONVA = 434 * MiB, WS_MEMY = 450 * MiB, WS_END = 502 * MiB;
constexpr int XCH_OFF = 131072;
constexpr int MISC_OFF = 139264;
constexpr size_t WS_BAR = 113 * MiB + 512 * 1024;
constexpr int LDS_BYTES = 147456;

static __device__ const double kInvFreqRev[32] = {
    0.15915494309189535, 0.11934937021124886, 0.08949940160889101, 0.06711508300522726, 0.050329212104487035, 0.03774158471741977, 0.0283021958306234, 0.02122365276477766,
    0.015915494309189534, 0.011934937021124886, 0.008949940160889102, 0.006711508300522725, 0.005032921210448704, 0.003774158471741977, 0.00283021958306234, 0.0021223652764777662,
    0.0015915494309189536, 0.0011934937021124885, 0.0008949940160889102, 0.0006711508300522726, 0.0005032921210448703, 0.00037741584717419774, 0.00028302195830623395, 0.0002122365276477766,
    0.00015915494309189535, 0.00011934937021124886, 8.949940160889102e-05, 6.711508300522725e-05, 5.0329212104487035e-05, 3.774158471741978e-05, 2.8302195830623396e-05, 2.122365276477766e-05};

__device__ __forceinline__ int fresh_tid(int wid0) { int l; asm volatile("v_mbcnt_lo_u32_b32 %0, -1, 0\n\tv_mbcnt_hi_u32_b32 %0, -1, %0" : "=v"(l)); return wid0 * 64 + l; }
__device__ __forceinline__ float shx(float v, int m, int lane) { return __int_as_float(__builtin_amdgcn_ds_bpermute((lane ^ m) << 2, __float_as_int(v))); }
__device__ __forceinline__ float bf_lo(unsigned u) { return __uint_as_float(u << 16); }
__device__ __forceinline__ float bf_hi(unsigned u) { return __uint_as_float(u & 0xffff0000u); }
__device__ __forceinline__ unsigned pk(float lo, float hi) { unsigned r; asm("s_nop 0\n\tv_cvt_pk_bf16_f32 %0, %1, %2" : "=v"(r) : "v"(lo), "v"(hi)); return r; }
typedef float f32x2_t __attribute__((ext_vector_type(2))); typedef __bf16 bf16x2_t __attribute__((ext_vector_type(2)));
__device__ __forceinline__ unsigned pkv(float lo, float hi) { const f32x2_t v = {lo, hi}; const bf16x2_t r = __builtin_convertvector(v, bf16x2_t); return __builtin_bit_cast(unsigned, r); }
__device__ __forceinline__ float sigm(float v) { return __builtin_amdgcn_rcpf(1.f + __builtin_amdgcn_exp2f(-LOG2E * v)); }
__device__ __forceinline__ float silu(float v) { return v * sigm(v); }
__device__ __forceinline__ u32x4 pk8(const f32x4& a, const f32x4& b) { u32x4 w; w.x = pk(a[0], a[1]); w.y = pk(a[2], a[3]); w.z = pk(b[0], b[1]); w.w = pk(b[2], b[3]); return w; }

struct Epi1 {
    static constexpr bool PERM = true, AFTER_DRAIN = false;
    bf16_t *cu, *bz, *cq, *ckv, *mlazs, *memq, *memzs, *gates; float *kr, *ssq;
    __device__ __forceinline__ void operator()(const f32x4 (&acc)[2][2][4][2], const pg8::Unit& u, int wr, int wc, int fr, int fq) const {
        const int pn = u.pn; const int row0 = u.pm * 256 + wr * 64 + fr;
        if (pn < 16) {
            const bool first = wc < 2; bf16_t* dst = (first ? cu : bz) + pn * 64 + (wc & 1) * 32 + 8 * fq;
#pragma unroll
            for (int ai = 0; ai < 2; ++ai)
#pragma unroll
                for (int m = 0; m < 4; ++m) {
                    f32x4 v0, v1;
#pragma unroll
                    for (int j = 0; j < 4; ++j) {
                        const float a0 = acc[ai][0][m][0][j], a1 = acc[ai][0][m][1][j], b0 = acc[ai][1][m][0][j], b1 = acc[ai][1][m][1][j];
                        v0[j] = a0 * (first ? b0 : silu(b0)); v1[j] = a1 * (first ? b1 : silu(b1)); }
                    *(u32x4*)(dst + (size_t)(row0 + ai * 128 + m * 16) * 1024) = pk8(v0, v1);
                }
            return;
        }
        if (pn == 20) {
            if (wc < 2) {
#pragma unroll
                for (int ai = 0; ai < 2; ++ai)
#pragma unroll
                    for (int m = 0; m < 4; ++m) { float* p = kr + (size_t)(row0 + ai * 128 + m * 16) * 64 + wc * 32 + 8 * fq;
                        *(f32x4*)p = acc[ai][0][m][0]; *(f32x4*)(p + 4) = acc[ai][0][m][1]; }
            }
            return;
        }
        bf16_t* dst; int ldc, col, act = 0; float* sq = nullptr;
        if (pn < 18)      { dst = cq;    ldc = 512;  col = (pn - 16) * 256; sq = ssq + (pn - 16) * 4 + wc; }
        else if (pn < 20) { dst = ckv;   ldc = 512;  col = (pn - 18) * 256; sq = ssq + (size_t)TB * 8 + (pn - 18) * 4 + wc; }
        else if (pn < 29) { dst = mlazs; ldc = 2048; col = (pn - 21) * 256; act = 1; }
        else if (pn < 33) { dst = memq;  ldc = 1024; col = (pn - 29) * 256; }
        else if (pn < 37) { dst = memzs; ldc = 1024; col = (pn - 33) * 256; act = 1; }
        else { const int g = (pn - 37) >> 3; dst = gates + (size_t)g * TB * 2048; ldc = 2048; col = ((pn - 37) & 7) * 256; act = 2; }
        dst += col + wc * 32 + 8 * fq;
#pragma unroll
        for (int ai = 0; ai < 2; ++ai)
#pragma unroll
            for (int m = 0; m < 4; ++m) {
                const int row = row0 + ai * 128 + m * 16; float s = 0.f;
#pragma unroll
                for (int bj = 0; bj < 2; ++bj) {
                    f32x4 v0 = acc[ai][bj][m][0], v1 = acc[ai][bj][m][1];
                    if (act == 1) {
#pragma unroll
                        for (int j = 0; j < 4; ++j) { v0[j] = silu(v0[j]); v1[j] = silu(v1[j]); }
                    } else if (act == 2) {
#pragma unroll
                        for (int j = 0; j < 4; ++j) { v0[j] = sigm(v0[j]); v1[j] = sigm(v1[j]); }
                    } else {
#pragma unroll
                        for (int j = 0; j < 4; ++j) s += v0[j] * v0[j] + v1[j] * v1[j];
                    }
                    *(u32x4*)(dst + (size_t)row * ldc + bj * 128) = pk8(v0, v1);
                }
                if (sq) { const int ln = fr + 16 * fq; s += shx(s, 16, ln); s += shx(s, 32, ln); if (fq == 0) sq[(size_t)row * 8] = s; }
            }
    }
};
struct EpiRowScale {
    static constexpr bool PERM = true, AFTER_DRAIN = false;
    bf16_t* O; int ldc; const float* ssq; float inv_k;
    __device__ __forceinline__ void operator()(const f32x4 (&acc)[2][2][4][2], const pg8::Unit& u, int wr, int wc, int fr, int fq) const {
        const int row0 = u.pm * 256 + wr * 64 + fr; bf16_t* dst = O + u.pn * 256 + wc * 32 + 8 * fq;
#pragma unroll
        for (int ai = 0; ai < 2; ++ai)
#pragma unroll
            for (int m = 0; m < 4; ++m) {
                const int row = row0 + ai * 128 + m * 16; float rs = 1.f;
                if (ssq) { const f32x4 a = *(const f32x4*)(ssq + (size_t)row * 8), b = *(const f32x4*)(ssq + (size_t)row * 8 + 4);
                    rs = __builtin_amdgcn_rsqf((((a[0] + a[1]) + (a[2] + a[3])) + ((b[0] + b[1]) + (b[2] + b[3]))) * inv_k + EPS); }
#pragma unroll
                for (int bj = 0; bj < 2; ++bj) *(u32x4*)(dst + (size_t)row * ldc + bj * 128) = pk8(acc[ai][bj][m][0] * rs, acc[ai][bj][m][1] * rs);
            }
    }
};
struct EpiKV {
    static constexpr bool PERM = true, AFTER_DRAIN = false;
    bf16_t* Kn; bf16_t* Vt; const float* ssq; const float* gk; LAS float* X;
    __device__ __forceinline__ void operator()(const f32x4 (&acc)[2][2][4][2], const pg8::Unit& u, int wr, int wc, int fr, int fq) const {
        const int h = u.pn; const int row0 = u.pm * 256 + wr * 64 + fr;
        float rsc[2][4];
#pragma unroll
        for (int ai = 0; ai < 2; ++ai)
#pragma unroll
            for (int m = 0; m < 4; ++m) {
                const int row = row0 + ai * 128 + m * 16;
                const f32x4 a = *(const f32x4*)(ssq + (size_t)row * 8), b = *(const f32x4*)(ssq + (size_t)row * 8 + 4);
                rsc[ai][m] = __builtin_amdgcn_rsqf((((a[0] + a[1]) + (a[2] + a[3])) + ((b[0] + b[1]) + (b[2] + b[3]))) * (1.f / 512.f) + EPS);
                float s = 0.f;
#pragma unroll
                for (int j = 0; j < 4; ++j) s += acc[ai][0][m][0][j] * acc[ai][0][m][0][j] + acc[ai][0][m][1][j] * acc[ai][0][m][1][j];
                { const int ln = fr + 16 * fq; s += shx(s, 16, ln); s += shx(s, 32, ln); }
                if (fq == 0) X[(ai * 128 + wr * 64 + m * 16 + fr) * 4 + wc] = s;
            }
        asm volatile("s_waitcnt lgkmcnt(0)" ::: "memory");
        __builtin_amdgcn_s_barrier();
        const f32x4 g0 = *(const f32x4*)(gk + wc * 32 + 8 * fq), g1 = *(const f32x4*)(gk + wc * 32 + 8 * fq + 4);
#pragma unroll
        for (int ai = 0; ai < 2; ++ai)
#pragma unroll
            for (int m = 0; m < 4; ++m) {
                const int row = row0 + ai * 128 + m * 16;
                const f32x4 p = *(const LAS f32x4*)(X + (ai * 128 + wr * 64 + m * 16 + fr) * 4);
                const float tot = (p[0] + p[1]) + (p[2] + p[3]);
                const float rk = __builtin_amdgcn_rsqf(tot * rsc[ai][m] * rsc[ai][m] * (1.f / 128.f) + EPS) * rsc[ai][m];
                *(u32x4*)(Kn + (size_t)row * 2048 + h * 128 + wc * 32 + 8 * fq) = pk8(acc[ai][0][m][0] * rk * g0, acc[ai][0][m][1] * rk * g1);
            }
#pragma unroll
        for (int ai = 0; ai < 2; ++ai) {
            bf16_t* img = Vt + (size_t)(h * 128 + u.pm * 4 + 2 * ai + wr) * 9216 + (wc * 32 + 8 * fq) * 72 + 4 * fr;
#pragma unroll
            for (int n = 0; n < 2; ++n)
#pragma unroll
                for (int j = 0; j < 4; ++j) { u32x2 w;
                    w.x = pk(acc[ai][1][0][n][j] * rsc[ai][0], acc[ai][1][1][n][j] * rsc[ai][1]); w.y = pk(acc[ai][1][2][n][j] * rsc[ai][2], acc[ai][1][3][n][j] * rsc[ai][3]);
                    *(u32x2*)(img + (4 * n + j) * 72) = w; }
        }
    }
};
struct EpiQKV {
    static constexpr bool PERM = true, AFTER_DRAIN = false;
    EpiRowScale q; EpiKV kv;
    __device__ __forceinline__ void operator()(const f32x4 (&acc)[2][2][4][2], const pg8::Unit& u, int wr, int wc, int fr, int fq) const { if (u.job) kv(acc, u, wr, wc, fr, fq); else q(acc, u, wr, wc, fr, fq); }
};
struct EpiGate {
    static constexpr bool PERM = true, AFTER_DRAIN = false;
    const bf16_t* G; bf16_t* Mg; int first;
    __device__ __forceinline__ void operator()(const f32x4 (&acc)[2][2][4][2], const pg8::Unit& u, int wr, int wc, int fr, int fq) const {
        const int row0 = u.pm * 256 + wr * 64 + fr; const int col0 = u.pn * 256 + wc * 32 + 8 * fq;
#pragma unroll
        for (int ai = 0; ai < 2; ++ai)
#pragma unroll
            for (int m = 0; m < 4; ++m)
#pragma unroll
                for (int bj = 0; bj < 2; ++bj) {
                    const size_t off = (size_t)(row0 + ai * 128 + m * 16) * 2048 + col0 + bj * 128;
                    const u32x4 g = *(const u32x4*)(G + off);
                    f32x4 v0 = acc[ai][bj][m][0], v1 = acc[ai][bj][m][1];
                    v0[0] *= bf_lo(g.x); v0[1] *= bf_hi(g.x); v0[2] *= bf_lo(g.y); v0[3] *= bf_hi(g.y);
                    v1[0] *= bf_lo(g.z); v1[1] *= bf_hi(g.z); v1[2] *= bf_lo(g.w); v1[3] *= bf_hi(g.w);
                    if (!first) { const u32x4 p = *(const u32x4*)(Mg + off);
                        v0[0] += bf_lo(p.x); v0[1] += bf_hi(p.x); v0[2] += bf_lo(p.y); v0[3] += bf_hi(p.y);
                        v1[0] += bf_lo(p.z); v1[1] += bf_hi(p.z); v1[2] += bf_lo(p.w); v1[3] += bf_hi(p.w); }
                    *(u32x4*)(Mg + off) = pk8(v0, v1);
                }
    }
};
struct EpiGate2 {
    static constexpr bool PERM = true, AFTER_DRAIN = false;
    EpiGate e0, e1;
    __device__ __forceinline__ void operator()(const f32x4 (&acc)[2][2][4][2], const pg8::Unit& u, int wr, int wc, int fr, int fq) const { if (u.job) e1(acc, u, wr, wc, fr, fq); else e0(acc, u, wr, wc, fr, fq); }
};
struct EpiOut {
    static constexpr bool PERM = true, AFTER_DRAIN = false;
    const float* X; float* O;
    __device__ __forceinline__ void operator()(const f32x4 (&acc)[2][2][4][2], const pg8::Unit& u, int wr, int wc, int fr, int fq) const {
        const int row0 = u.pm * 256 + wr * 64 + fr; const int col0 = u.pn * 256 + wc * 32 + 8 * fq;
#pragma unroll
        for (int ai = 0; ai < 2; ++ai)
#pragma unroll
            for (int m = 0; m < 4; ++m)
#pragma unroll
                for (int bj = 0; bj < 2; ++bj) {
                    const size_t off = (size_t)(row0 + ai * 128 + m * 16) * 2048 + col0 + bj * 128;
                    const f32x4 x0 = *(const f32x4*)(X + off), x1 = *(const f32x4*)(X + off + 4);
                    *(f32x4*)(O + off) = x0 + acc[ai][bj][m][0]; *(f32x4*)(O + off + 4) = x1 + acc[ai][bj][m][1];
                }
    }
};

__device__ __forceinline__ void transpose_tile(LAS unsigned char* lds, const float* W, int Nsrc, int ns0, int K, int k0, bf16_t* Wt, int nd0, const float* gk, const int wid0) {
    const int tid = fresh_tid(wid0); LAS bf16_t* T = (LAS bf16_t*)lds;
    if (ns0 >= 0) {
#pragma unroll
        for (int p = 0; p < 4; ++p) {
            const int kk = p * 32 + (tid >> 4), n4 = (tid & 15) * 4;
            f32x4 v = *(const f32x4*)(W + (size_t)(k0 + kk) * Nsrc + ns0 + n4);
            if (gk) v = v * gk[k0 + kk];
            const unsigned a = pk(v[0], v[1]), b = pk(v[2], v[3]);
            T[(n4 + 0) * 136 + kk] = (bf16_t)(a & 0xffffu); T[(n4 + 1) * 136 + kk] = (bf16_t)(a >> 16);
            T[(n4 + 2) * 136 + kk] = (bf16_t)(b & 0xffffu); T[(n4 + 3) * 136 + kk] = (bf16_t)(b >> 16);
        }
    }
    __syncthreads();
#pragma unroll
    for (int p = 0; p < 2; ++p) {
        const int n = p * 32 + (tid >> 4), c = tid & 15;
        u32x4 o = (u32x4){0u, 0u, 0u, 0u};
        if (ns0 >= 0) o = *(const LAS u32x4*)(T + n * 136 + c * 8);
        *(u32x4*)(Wt + (size_t)(nd0 + n) * K + k0 + c * 8) = o;
    }
    __syncthreads();
}
__device__ __forceinline__ float wave_sum(float v, int lane) {
#pragma unroll
    for (int o = 1; o < 64; o <<= 1) v += shx(v, o, lane);
    return v;
}
__device__ __forceinline__ void rms_row(const float* xrow, const float* g, bf16_t* orow, int lane) {
    const f32x4* xr = (const f32x4*)xrow + lane; const f32x4* gr = (const f32x4*)g + lane;
    f32x4 v[8]; float s = 0.f;
#pragma unroll
    for (int j = 0; j < 8; ++j) { v[j] = xr[64 * j]; s += (v[j][0] * v[j][0] + v[j][1] * v[j][1]) + (v[j][2] * v[j][2] + v[j][3] * v[j][3]); }
    const float rs = __builtin_amdgcn_rsqf(wave_sum(s, lane) * (1.f / 2048.f) + EPS);
    u32x2* o8 = (u32x2*)orow + lane;
#pragma unroll
    for (int j = 0; j < 8; ++j) { const f32x4 gg = gr[64 * j]; u32x2 w; w.x = pk(v[j][0] * rs * gg[0], v[j][1] * rs * gg[1]); w.y = pk(v[j][2] * rs * gg[2], v[j][3] * rs * gg[3]); o8[64 * j] = w; }
}
__device__ __forceinline__ void rms_row2(const float* xa, const float* xb, const float* g, bf16_t* oa, bf16_t* ob, int lane) {
    const f32x4* pa = (const f32x4*)xa + lane; const f32x4* pb = (const f32x4*)xb + lane; const f32x4* gr = (const f32x4*)g + lane;
    f32x4 va[8], vb[8]; float sa = 0.f, sb = 0.f;
#pragma unroll
    for (int j = 0; j < 8; ++j) { va[j] = pa[64 * j]; vb[j] = pb[64 * j]; }
#pragma unroll
    for (int j = 0; j < 8; ++j) { sa += (va[j][0] * va[j][0] + va[j][1] * va[j][1]) + (va[j][2] * va[j][2] + va[j][3] * va[j][3]); sb += (vb[j][0] * vb[j][0] + vb[j][1] * vb[j][1]) + (vb[j][2] * vb[j][2] + vb[j][3] * vb[j][3]); }
    const float ra = __builtin_amdgcn_rsqf(wave_sum(sa, lane) * (1.f / 2048.f) + EPS), rb = __builtin_amdgcn_rsqf(wave_sum(sb, lane) * (1.f / 2048.f) + EPS);
    u32x2* qa = (u32x2*)oa + lane; u32x2* qb = (u32x2*)ob + lane;
#pragma unroll
    for (int j = 0; j < 8; ++j) { const f32x4 gg = gr[64 * j]; u32x2 w;
        w.x = pk(va[j][0] * ra * gg[0], va[j][1] * ra * gg[1]); w.y = pk(va[j][2] * ra * gg[2], va[j][3] * ra * gg[3]); qa[64 * j] = w;
        w.x = pk(vb[j][0] * rb * gg[0], vb[j][1] * rb * gg[1]); w.y = pk(vb[j][2] * rb * gg[2], vb[j][3] * rb * gg[3]); qb[64 * j] = w; }
}
__device__ __forceinline__ void vt_item(LAS unsigned char* lds, const bf16_t* src, int pitch, bf16_t* dst, const int wid0) {
    const int tid = fresh_tid(wid0); LAS bf16_t* T = (LAS bf16_t*)lds;
#pragma unroll
    for (int p = 0; p < 2; ++p) {
        const int c = tid + 512 * p, key = c >> 4, d8 = (c & 15) * 8;
        const u32x4 v = *(const u32x4*)(src + (size_t)key * pitch + d8);
        const int pos = 4 * (key & 15) + (key >> 4);
        T[(d8 + 0) * 72 + pos] = (bf16_t)(v.x & 0xffffu); T[(d8 + 1) * 72 + pos] = (bf16_t)(v.x >> 16);
        T[(d8 + 2) * 72 + pos] = (bf16_t)(v.y & 0xffffu); T[(d8 + 3) * 72 + pos] = (bf16_t)(v.y >> 16);
        T[(d8 + 4) * 72 + pos] = (bf16_t)(v.z & 0xffffu); T[(d8 + 5) * 72 + pos] = (bf16_t)(v.z >> 16);
        T[(d8 + 6) * 72 + pos] = (bf16_t)(v.w & 0xffffu); T[(d8 + 7) * 72 + pos] = (bf16_t)(v.w >> 16);
    }
    __syncthreads();
#pragma unroll
    for (int p = 0; p < 3; ++p) { const int c = tid + 512 * p; if (c < 1152) *(u32x4*)(dst + c * 8) = *(const LAS u32x4*)(T + c * 8); }
    __syncthreads();
}
template <int W> __device__ __forceinline__ void norm_row16(bf16_t* row, const float* g, int sub, int lane) {
    constexpr int NC = W / 128;
    u32x4 r[NC]; float s = 0.f;
#pragma unroll
    for (int c = 0; c < NC; ++c) { r[c] = *(const u32x4*)(row + c * 128 + sub * 8);
#pragma unroll
        for (int e = 0; e < 4; ++e) { const float a = bf_lo(r[c][e]), b = bf_hi(r[c][e]); s += a * a + b * b; } }
    s += shx(s, 1, lane); s += shx(s, 2, lane); s += shx(s, 4, lane); s += shx(s, 8, lane);
    const float rs = __builtin_amdgcn_rsqf(s * (1.f / W) + EPS);
#pragma unroll
    for (int c = 0; c < NC; ++c) { const f32x4 g0 = *(const f32x4*)(g + c * 128 + sub * 8), g1 = *(const f32x4*)(g + c * 128 + sub * 8 + 4); u32x4 o;
        o.x = pk(bf_lo(r[c].x) * rs * g0[0], bf_hi(r[c].x) * rs * g0[1]); o.y = pk(bf_lo(r[c].y) * rs * g0[2], bf_hi(r[c].y) * rs * g0[3]);
        o.z = pk(bf_lo(r[c].z) * rs * g1[0], bf_hi(r[c].z) * rs * g1[1]); o.w = pk(bf_lo(r[c].w) * rs * g1[2], bf_hi(r[c].w) * rs * g1[3]);
        *(u32x4*)(row + c * 128 + sub * 8) = o; }
}

template <int DQK, bool MLA>
__device__ __forceinline__ void attn_unit(LAS unsigned char* lds, const bf16_t* Q, int qpitch, const float* g1, const float* g2, const float* cosT, const float* sinT, float qscale,
                                          const bf16_t* Ka, int kapitch, const bf16_t* Kb, const bf16_t* Vt, int NT, int tmax_off, const bf16_t* Z, bf16_t* O, int opitch, const int wid0) {
    constexpr int KS = DQK / 16, KPITCH = DQK * 2 + 16, KT_BYTES = 64 * KPITCH, VT_BYTES = 18432, CPR = DQK / 8, NKC = (64 * CPR) / NTHR;
    const int tid = fresh_tid(wid0), lane = tid & 63, r32 = lane & 31, hi = lane >> 5; const int wid = wid0;
    const int tmax_w = MLA ? (tmax_off + (wid >> 1)) : tmax_off;
    bf16x8 qf[KS];
    {
        const bf16_t* qrow = Q + (size_t)(wid * 32 + r32) * qpitch + hi * 8;
        u32x4 raw[KS];
#pragma unroll
        for (int d0 = 0; d0 < KS; ++d0) raw[d0] = *(const u32x4*)(qrow + d0 * 16);
        constexpr int NS1 = MLA ? 8 : KS;
        float s1 = 0.f, s2 = 0.f;
#pragma unroll
        for (int d0 = 0; d0 < KS; ++d0)
#pragma unroll
            for (int e = 0; e < 4; ++e) { const float a = bf_lo(raw[d0][e]), b = bf_hi(raw[d0][e]); if (d0 < NS1) s1 += a * a + b * b; else s2 += a * a + b * b; }
        s1 += shx(s1, 32, lane); s2 += shx(s2, 32, lane);
        const float rs1 = __builtin_amdgcn_rsqf(s1 * (MLA ? (1.f / 128.f) : (1.f / 256.f)) + EPS) * qscale;
#pragma unroll
        for (int d0 = 0; d0 < NS1; ++d0) {
            const f32x4 ga = *(const f32x4*)(g1 + d0 * 16 + hi * 8), gb = *(const f32x4*)(g1 + d0 * 16 + hi * 8 + 4); u32x4 o;
            o.x = pk(bf_lo(raw[d0].x) * rs1 * ga[0], bf_hi(raw[d0].x) * rs1 * ga[1]); o.y = pk(bf_lo(raw[d0].y) * rs1 * ga[2], bf_hi(raw[d0].y) * rs1 * ga[3]);
            o.z = pk(bf_lo(raw[d0].z) * rs1 * gb[0], bf_hi(raw[d0].z) * rs1 * gb[1]); o.w = pk(bf_lo(raw[d0].w) * rs1 * gb[2], bf_hi(raw[d0].w) * rs1 * gb[3]);
            qf[d0] = __builtin_bit_cast(bf16x8, o);
        }
        if constexpr (MLA) {
            const float rs2 = __builtin_amdgcn_rsqf(s2 * (1.f / 64.f) + EPS) * qscale;
            const float* cr = cosT + (size_t)(wid * 32 + r32) * 32; const float* sr = sinT + (size_t)(wid * 32 + r32) * 32;
#pragma unroll
            for (int dd = 0; dd < 2; ++dd) {
                const int i0 = dd * 16 + hi * 8;
                float x1[8], x2[8], y1[8], y2[8];
#pragma unroll
                for (int e = 0; e < 4; ++e) { x1[2 * e] = bf_lo(raw[8 + dd][e]); x1[2 * e + 1] = bf_hi(raw[8 + dd][e]); x2[2 * e] = bf_lo(raw[10 + dd][e]); x2[2 * e + 1] = bf_hi(raw[10 + dd][e]); }
#pragma unroll
                for (int e = 0; e < 8; ++e) {
                    const float a = x1[e] * rs2 * g2[i0 + e], b = x2[e] * rs2 * g2[32 + i0 + e], c = cr[i0 + e], s = sr[i0 + e];
                    y1[e] = a * c - b * s; y2[e] = b * c + a * s; }
                u32x4 o1, o2;
                o1.x = pk(y1[0], y1[1]); o1.y = pk(y1[2], y1[3]); o1.z = pk(y1[4], y1[5]); o1.w = pk(y1[6], y1[7]);
                o2.x = pk(y2[0], y2[1]); o2.y = pk(y2[2], y2[3]); o2.z = pk(y2[4], y2[5]); o2.w = pk(y2[6], y2[7]);
                qf[8 + dd] = __builtin_bit_cast(bf16x8, o1); qf[10 + dd] = __builtin_bit_cast(bf16x8, o2);
            }
        }
    }
    u32x4 kreg[NKC], vreg[3];
    auto load_tile = [&](int t) {
#pragma unroll
        for (int i = 0; i < NKC; ++i) { const int c = tid + NTHR * i, row = c / CPR, cc = c % CPR; const size_t key = (size_t)t * 64 + row;
            const bf16_t* src = (MLA && cc >= 16) ? (Kb + key * 64 + (cc - 16) * 8) : (Ka + key * kapitch + cc * 8);
            kreg[i] = *(const u32x4*)src; }
        const bf16_t* vs = Vt + (size_t)t * 9216;
        vreg[0] = *(const u32x4*)(vs + tid * 8); vreg[1] = *(const u32x4*)(vs + (tid + 512) * 8);
        if (tid < 128) vreg[2] = *(const u32x4*)(vs + (tid + 1024) * 8);
    };
    auto store_tile = [&](int buf) {
        LAS unsigned char* kb = lds + buf * KT_BYTES; LAS unsigned char* vb = lds + 2 * KT_BYTES + buf * VT_BYTES;
#pragma unroll
        for (int i = 0; i < NKC; ++i) { const int c = tid + NTHR * i, key = c / CPR, cc = c % CPR; const int row = ((key & 12) << 2) + ((key & 1) << 3) + ((key & 2) << 1) + (key >> 4);
            *(LAS u32x4*)(kb + row * KPITCH + cc * 16) = kreg[i]; }
        *(LAS u32x4*)(vb + tid * 16) = vreg[0]; *(LAS u32x4*)(vb + (tid + 512) * 16) = vreg[1];
        if (tid < 128) *(LAS u32x4*)(vb + (tid + 1024) * 16) = vreg[2];
    };
    f32x16 o[4];
#pragma unroll
    for (int d = 0; d < 4; ++d)
#pragma unroll
        for (int i = 0; i < 16; ++i) o[d][i] = 0.f;
    float l_run = 0.f;
    load_tile(0); store_tile(0); __syncthreads();
    for (int t = 0; t < NT; ++t) {
        const bool more = (t + 1 < NT);
        if (more) load_tile(t + 1);
        if (t <= tmax_w) {
            const LAS unsigned char* kb = lds + (t & 1) * KT_BYTES + r32 * KPITCH + hi * 16;
            const LAS unsigned char* vb = lds + 2 * KT_BYTES + (t & 1) * VT_BYTES + r32 * 144 + hi * 16;
            f32x16 p0, p1;
#pragma unroll
            for (int i = 0; i < 16; ++i) { p0[i] = 0.f; p1[i] = 0.f; }
#pragma unroll
            for (int d0 = 0; d0 < KS; ++d0) {
                const bf16x8 k0 = *(const LAS bf16x8*)(kb + d0 * 32), k1 = *(const LAS bf16x8*)(kb + 32 * KPITCH + d0 * 32);
                p0 = __builtin_amdgcn_mfma_f32_32x32x16_bf16(k0, qf[d0], p0, 0, 0, 0);
                p1 = __builtin_amdgcn_mfma_f32_32x32x16_bf16(k1, qf[d0], p1, 0, 0, 0);
            }
            float rsum = 0.f;
#pragma unroll
            for (int i = 0; i < 16; ++i) { p0[i] = __builtin_amdgcn_exp2f(p0[i]); p1[i] = __builtin_amdgcn_exp2f(p1[i]); rsum += p0[i] + p1[i]; }
            l_run += rsum;
#pragma unroll
            for (int ks = 0; ks < 4; ++ks) {
                u32x4 w;
                if (ks < 2) { const int b = 8 * (ks & 1); w.x = pk(p0[b], p0[b + 1]); w.y = pk(p0[b + 2], p0[b + 3]); w.z = pk(p0[b + 4], p0[b + 5]); w.w = pk(p0[b + 6], p0[b + 7]); }
                else        { const int b = 8 * (ks & 1); w.x = pk(p1[b], p1[b + 1]); w.y = pk(p1[b + 2], p1[b + 3]); w.z = pk(p1[b + 4], p1[b + 5]); w.w = pk(p1[b + 6], p1[b + 7]); }
                const bf16x8 pb = __builtin_bit_cast(bf16x8, w);
#pragma unroll
                for (int d = 0; d < 4; ++d) {
                    const bf16x8 va = *(const LAS bf16x8*)(vb + d * (32 * 144) + ks * 32);
                    o[d] = __builtin_amdgcn_mfma_f32_32x32x16_bf16(va, pb, o[d], 0, 0, 0);
                }
            }
        }
        if (more) store_tile((t + 1) & 1);
        __syncthreads();
    }
    l_run += shx(l_run, 32, lane);
    const float inv = 1.f / l_run;
    const size_t rowoff = (size_t)(wid * 32 + r32) * opitch;
#pragma unroll
    for (int d = 0; d < 4; ++d)
#pragma unroll
        for (int gp = 0; gp < 2; ++gp) {
            const int col = 32 * d + 16 * gp + 8 * hi;
            const u32x4 z = *(const u32x4*)(Z + rowoff + col);
            const auto z0 = __builtin_amdgcn_permlane32_swap(z.x, z.z, false, false), z1 = __builtin_amdgcn_permlane32_swap(z.y, z.w, false, false);
            const int g = 2 * gp;
            unsigned a0 = pkv(o[d][4 * g + 0] * inv * bf_lo(z0[0]), o[d][4 * g + 1] * inv * bf_hi(z0[0]));
            unsigned a1 = pkv(o[d][4 * g + 2] * inv * bf_lo(z1[0]), o[d][4 * g + 3] * inv * bf_hi(z1[0]));
            unsigned b0 = pkv(o[d][4 * g + 4] * inv * bf_lo(z0[1]), o[d][4 * g + 5] * inv * bf_hi(z0[1]));
            unsigned b1 = pkv(o[d][4 * g + 6] * inv * bf_lo(z1[1]), o[d][4 * g + 7] * inv * bf_hi(z1[1]));
            const auto w0 = __builtin_amdgcn_permlane32_swap(a0, b0, false, false), w1 = __builtin_amdgcn_permlane32_swap(a1, b1, false, false);
            u32x4 w; w.x = w0[0]; w.y = w1[0]; w.z = w0[1]; w.w = w1[1];
            *(u32x4*)(O + rowoff + col) = w;
        }
}

template <int DQK, bool MLA>
__device__ __forceinline__ void attn_unit2(LAS unsigned char* lds, const bf16_t* Q, int qpitch, const float* g1, const float* g2, const float* cosT, const float* sinT, float qscale,
                                           const bf16_t* Ka, int kapitch, const bf16_t* Kb, const bf16_t* Vt, int NT, int tmax_off, const bf16_t* Z, bf16_t* O, int opitch, const int wid0) {
    constexpr int KS = DQK / 16, KPITCH = DQK * 2 + 16, KT_BYTES = 64 * KPITCH, VT_BYTES = 18432, CPR = DQK / 8, NKC = (64 * CPR) / NTHR;
    const int tid = fresh_tid(wid0), lane = tid & 63, r32 = lane & 31, hi = lane >> 5; const int wid = wid0;
    const int tmax_w = MLA ? (tmax_off + (wid >> 1)) : tmax_off;
    u32x4 kreg[NKC], vreg[3];
    unsigned ksrc[NKC], kdst[NKC];
#pragma unroll
    for (int i = 0; i < NKC; ++i) {
        int key, cc; bool rope = false;
        if constexpr (MLA) { if (i < 2) { const int c = tid + NTHR * i; key = c >> 4; cc = c & 15; } else { key = tid >> 3; cc = 16 + (tid & 7); rope = true; } }
        else { const int c = tid + NTHR * i; key = c >> 5; cc = c & 31; }
        ksrc[i] = rope ? (unsigned)(key * 128 + (cc - 16) * 16) : (unsigned)(key * kapitch * 2 + cc * 16);
        const int row = ((key & 12) << 2) + ((key & 1) << 3) + ((key & 2) << 1) + (key >> 4);
        kdst[i] = (unsigned)(row * KPITCH + cc * 16);
    }
    auto gload_k = [&](int t) __attribute__((always_inline)) {
        const char* ka = (const char*)(Ka + (size_t)t * 64 * kapitch); const char* kb2 = (const char*)(Kb + (size_t)t * 64 * 64);
#pragma unroll
        for (int i = 0; i < NKC; ++i) kreg[i] = *(const u32x4*)(((MLA && i >= 2) ? kb2 : ka) + ksrc[i]);
    };
    auto gload_v = [&](int t) __attribute__((always_inline)) {
        const char* vs = (const char*)(Vt + (size_t)t * 9216);
        vreg[0] = *(const u32x4*)(vs + (unsigned)tid * 16u); vreg[1] = *(const u32x4*)(vs + (unsigned)tid * 16u + 8192u);
        if (tid < 128) vreg[2] = *(const u32x4*)(vs + (unsigned)tid * 16u + 16384u);
    };
    auto sts_k = [&](int kofs) __attribute__((always_inline)) {
        LAS unsigned char* kb = lds + kofs;
#pragma unroll
        for (int i = 0; i < NKC; ++i) *(LAS u32x4*)(kb + kdst[i]) = kreg[i];
    };
    auto sts_v = [&](int buf) __attribute__((always_inline)) {
        LAS unsigned char* vb = lds + 3 * KT_BYTES + buf * VT_BYTES;
        *(LAS u32x4*)(vb + tid * 16) = vreg[0]; *(LAS u32x4*)(vb + (tid + 512) * 16) = vreg[1];
        if (tid < 128) *(LAS u32x4*)(vb + (tid + 1024) * 16) = vreg[2];
    };
    gload_k(0); gload_v(0);
    u32x4 kreg1[NKC];
    { const char* ka = (const char*)(Ka + (size_t)64 * kapitch); const char* kb2 = (const char*)(Kb + (size_t)64 * 64);
#pragma unroll
      for (int i = 0; i < NKC; ++i) kreg1[i] = *(const u32x4*)(((MLA && i >= 2) ? kb2 : ka) + ksrc[i]); }
    bf16x8 qf[KS];
    {
        const bf16_t* qrow = Q + (size_t)(wid * 32 + r32) * qpitch + hi * 8;
        u32x4 raw[KS];
#pragma unroll
        for (int d0 = 0; d0 < KS; ++d0) raw[d0] = *(const u32x4*)(qrow + d0 * 16);
        constexpr int NS1 = MLA ? 8 : KS;
        float s1 = 0.f, s2 = 0.f;
#pragma unroll
        for (int d0 = 0; d0 < KS; ++d0)
#pragma unroll
            for (int e = 0; e < 4; ++e) { const float a = bf_lo(raw[d0][e]), b = bf_hi(raw[d0][e]); if (d0 < NS1) s1 += a * a + b * b; else s2 += a * a + b * b; }
        s1 += shx(s1, 32, lane); s2 += shx(s2, 32, lane);
        const float rs1 = __builtin_amdgcn_rsqf(s1 * (MLA ? (1.f / 128.f) : (1.f / 256.f)) + EPS) * qscale;
#pragma unroll
        for (int d0 = 0; d0 < NS1; ++d0) {
            const f32x4 ga = *(const f32x4*)(g1 + d0 * 16 + hi * 8), gb = *(const f32x4*)(g1 + d0 * 16 + hi * 8 + 4); u32x4 o;
            o.x = pk(bf_lo(raw[d0].x) * rs1 * ga[0], bf_hi(raw[d0].x) * rs1 * ga[1]); o.y = pk(bf_lo(raw[d0].y) * rs1 * ga[2], bf_hi(raw[d0].y) * rs1 * ga[3]);
            o.z = pk(bf_lo(raw[d0].z) * rs1 * gb[0], bf_hi(raw[d0].z) * rs1 * gb[1]); o.w = pk(bf_lo(raw[d0].w) * rs1 * gb[2], bf_hi(raw[d0].w) * rs1 * gb[3]);
            qf[d0] = __builtin_bit_cast(bf16x8, o);
        }
        if constexpr (MLA) {
            const float rs2 = __builtin_amdgcn_rsqf(s2 * (1.f / 64.f) + EPS) * qscale;
            const float* cr = cosT + (size_t)(wid * 32 + r32) * 32; const float* sr = sinT + (size_t)(wid * 32 + r32) * 32;
#pragma unroll
            for (int dd = 0; dd < 2; ++dd) {
                const int i0 = dd * 16 + hi * 8;
                float x1[8], x2[8], y1[8], y2[8];
#pragma unroll
                for (int e = 0; e < 4; ++e) { x1[2 * e] = bf_lo(raw[8 + dd][e]); x1[2 * e + 1] = bf_hi(raw[8 + dd][e]); x2[2 * e] = bf_lo(raw[10 + dd][e]); x2[2 * e + 1] = bf_hi(raw[10 + dd][e]); }
#pragma unroll
                for (int e = 0; e < 8; ++e) {
                    const float a = x1[e] * rs2 * g2[i0 + e], b = x2[e] * rs2 * g2[32 + i0 + e], c = cr[i0 + e], s = sr[i0 + e];
                    y1[e] = a * c - b * s; y2[e] = b * c + a * s; }
                u32x4 o1, o2;
                o1.x = pk(y1[0], y1[1]); o1.y = pk(y1[2], y1[3]); o1.z = pk(y1[4], y1[5]); o1.w = pk(y1[6], y1[7]);
                o2.x = pk(y2[0], y2[1]); o2.y = pk(y2[2], y2[3]); o2.z = pk(y2[4], y2[5]); o2.w = pk(y2[6], y2[7]);
                qf[8 + dd] = __builtin_bit_cast(bf16x8, o1); qf[10 + dd] = __builtin_bit_cast(bf16x8, o2);
            }
        }
    }
    f32x16 o[4];
#pragma unroll
    for (int d = 0; d < 4; ++d)
#pragma unroll
        for (int i = 0; i < 16; ++i) o[d][i] = 0.f;
    float l_run = 0.f;
    f32x16 sX, sY;
    sts_k(0); sts_v(0);
#pragma unroll
    for (int i = 0; i < NKC; ++i) *(LAS u32x4*)(lds + KT_BYTES + kdst[i]) = kreg1[i];
    __syncthreads();
    {
        const LAS unsigned char* kb = lds + r32 * KPITCH + hi * 16;
#pragma unroll
        for (int i = 0; i < 16; ++i) sX[i] = 0.f;
#pragma unroll
        for (int d0 = 0; d0 < KS; ++d0) sX = __builtin_amdgcn_mfma_f32_32x32x16_bf16(*(const LAS bf16x8*)(kb + d0 * 32), qf[d0], sX, 0, 0, 0);
    }
    __syncthreads();
    bf16x8 kp0, kp1;
    { const LAS unsigned char* kb = lds + 32 * KPITCH + r32 * KPITCH + hi * 16; kp0 = *(const LAS bf16x8*)(kb); kp1 = *(const LAS bf16x8*)(kb + 32); }
    float rs_early = 0.f;
    {
        float s = 0.f;
#pragma unroll
        for (int e = 0; e < 6; ++e) { const float x = __builtin_amdgcn_exp2f(sX[e]); sX[e] = x; s += x; }
        rs_early = s;
    }
    auto substep = [&](f32x16& a, f32x16& b, int knext_ofs, int vofs, int h, int kafter_ofs) __attribute__((always_inline)) {
        const LAS unsigned char* kb = lds + knext_ofs + r32 * KPITCH + hi * 16;
        const LAS unsigned char* vb = lds + vofs + r32 * 144 + hi * 16 + h * 64;
        u32x4 pw0, pw1; bf16x8 vf0[4], vf1[4], kr[3];
        kr[0] = kp0; kr[1] = kp1;
        float rs0 = rs_early;
        __builtin_amdgcn_sched_barrier(0);
#pragma unroll
        for (int d0 = 0; d0 < KS; ++d0) {
            if (d0 + 2 < KS) kr[(d0 + 2) % 3] = *(const LAS bf16x8*)(kb + (d0 + 2) * 32);
            if (d0 == KS - 3) {
#pragma unroll
                for (int d = 0; d < 4; ++d) vf0[d] = *(const LAS bf16x8*)(vb + d * 4608);
            }
            if (d0 == 0) { const f32x16 z16 = {0.f, 0.f, 0.f, 0.f, 0.f, 0.f, 0.f, 0.f, 0.f, 0.f, 0.f, 0.f, 0.f, 0.f, 0.f, 0.f};
                b = __builtin_amdgcn_mfma_f32_32x32x16_bf16(kr[0], qf[0], z16, 0, 0, 0); }
            else b = __builtin_amdgcn_mfma_f32_32x32x16_bf16(kr[d0 % 3], qf[d0], b, 0, 0, 0);
#pragma unroll
            for (int e = 6 + (10 * d0) / KS; e < 6 + (10 * (d0 + 1)) / KS; ++e) {
                const float x = __builtin_amdgcn_exp2f(a[e]);
                a[e] = x;
                rs0 += x;
                if (e == 7)  { pw0.x = pk(a[0], a[1]); pw0.y = pk(a[2], a[3]);   pw0.z = pk(a[4], a[5]);   pw0.w = pk(a[6], a[7]); }
                if (e == 15) { pw1.x = pk(a[8], a[9]); pw1.y = pk(a[10], a[11]); pw1.z = pk(a[12], a[13]); pw1.w = pk(a[14], a[15]); }
            }
            __builtin_amdgcn_sched_barrier(0);
        }
        l_run += rs0;
        float rs_n = 0.f;
#pragma unroll
        for (int kk = 0; kk < 2; ++kk) {
            if (kk == 0) {
#pragma unroll
                for (int d = 0; d < 4; ++d) vf1[d] = *(const LAS bf16x8*)(vb + d * 4608 + 32);
            } else { const LAS unsigned char* ka = lds + kafter_ofs + r32 * KPITCH + hi * 16; kp0 = *(const LAS bf16x8*)(ka); kp1 = *(const LAS bf16x8*)(ka + 32); }
            const bf16x8 pb = __builtin_bit_cast(bf16x8, kk ? pw1 : pw0);
#pragma unroll
            for (int d = 0; d < 4; ++d) {
                o[d] = __builtin_amdgcn_mfma_f32_32x32x16_bf16(kk ? vf1[d] : vf0[d], pb, o[d], 0, 0, 0);
                const int e = 4 * kk + d - 2;
                if (e >= 0) { const float x = __builtin_amdgcn_exp2f(b[e]); b[e] = x; rs_n += x; }
            }
            __builtin_amdgcn_sched_barrier(0);
        }
        rs_early = rs_n;
    };
    int kc = 0, kn = KT_BYTES, kn2 = 2 * KT_BYTES;
    for (int t = 0; t < NT; ++t) {
        const bool has_k2 = (t + 2 < NT), has_v1 = (t + 1 < NT), active = (t <= tmax_w);
        const int vofs = 3 * KT_BYTES + (t & 1) * VT_BYTES;
        if (has_k2) gload_k(t + 2);
        if (has_v1) gload_v(t + 1);
        if (active) substep(sX, sY, kc + 32 * KPITCH, vofs, 0, kn);
        if (active) substep(sY, sX, kn, vofs, 1, kn + 32 * KPITCH);
        if (has_k2) sts_k(kn2);
        if (has_v1) sts_v((t + 1) & 1);
        __syncthreads();
        const int tmp = kc; kc = kn; kn = kn2; kn2 = tmp;
    }
    { auto rr = __builtin_amdgcn_permlane32_swap(__float_as_uint(l_run), __float_as_uint(l_run), false, false); l_run = __uint_as_float(rr[0]) + __uint_as_float(rr[1]); }
    const float inv = 1.f / l_run;
    const int tid_e = fresh_tid(wid0), hi_e = (tid_e >> 5) & 1;
    const size_t rowoff = (size_t)(wid * 32 + (tid_e & 31)) * opitch;
#pragma unroll
    for (int d = 0; d < 4; ++d)
#pragma unroll
        for (int gp = 0; gp < 2; ++gp) {
            const int col = 32 * d + 16 * gp + 8 * hi_e;
            const u32x4 z = *(const u32x4*)(Z + rowoff + col);
            const auto z0 = __builtin_amdgcn_permlane32_swap(z.x, z.z, false, false), z1 = __builtin_amdgcn_permlane32_swap(z.y, z.w, false, false);
            const int g = 2 * gp;
            unsigned a0 = pkv(o[d][4 * g + 0] * inv * bf_lo(z0[0]), o[d][4 * g + 1] * inv * bf_hi(z0[0]));
            unsigned a1 = pkv(o[d][4 * g + 2] * inv * bf_lo(z1[0]), o[d][4 * g + 3] * inv * bf_hi(z1[0]));
            unsigned b0 = pkv(o[d][4 * g + 4] * inv * bf_lo(z0[1]), o[d][4 * g + 5] * inv * bf_hi(z0[1]));
            unsigned b1 = pkv(o[d][4 * g + 6] * inv * bf_lo(z1[1]), o[d][4 * g + 7] * inv * bf_hi(z1[1]));
            const auto w0 = __builtin_amdgcn_permlane32_swap(a0, b0, false, false), w1 = __builtin_amdgcn_permlane32_swap(a1, b1, false, false);
            u32x4 w; w.x = w0[0]; w.y = w1[0]; w.z = w0[1]; w.w = w1[1];
            *(u32x4*)(O + rowoff + col) = w;
        }
}

#define XB_TMO      128
#define XB_XCNT(j)  (256  + 64 * (j))
#define XB_XSUB(j)  (1280 + 64 * (j))
#define XB_XGEN(j)  (2304 + 64 * (j))
#define XB_TOP      3328
#define XB_TOPGEN   3392
#define XCD_BAR_WORDS 3456
#define XB_SPIN_CAP (1u << 18)
__device__ __forceinline__ unsigned xb_ld(unsigned* p)              { return __hip_atomic_load(p, __ATOMIC_RELAXED, __HIP_MEMORY_SCOPE_AGENT); }
__device__ __forceinline__ unsigned xb_add(unsigned* p, unsigned v) { return __hip_atomic_fetch_add(p, v, __ATOMIC_RELAXED, __HIP_MEMORY_SCOPE_AGENT); }
__device__ __forceinline__ unsigned xb_xcc_id() { return (unsigned)__builtin_amdgcn_s_getreg((3 << 11) | 20) & 0xFu; }
#define XB_SPIN(cond, bar) do { unsigned _sp = 0; while (cond) { __builtin_amdgcn_s_sleep(1); \
    if ((++_sp & 255u) == 0u) { if (xb_ld(&(bar)[XB_TMO])) break; if (_sp > XB_SPIN_CAP) { atomicAdd(&(bar)[XB_TMO], 1u); break; } } } } while (0)
__device__ __forceinline__ void xcd_barrier_complete(unsigned* bar, unsigned x, unsigned& nloc, unsigned& nx) {
    const unsigned G = gridDim.x * gridDim.y * gridDim.z;
    unsigned sum, cnt, mine, sp = 0u;
    for (;;) {
        sum = 0u; cnt = 0u; mine = 0u;
#pragma unroll
        for (unsigned j = 0; j < 16; ++j) { const unsigned c = xb_ld(&bar[XB_XCNT(j)]); sum += c; cnt += (c > 0u) ? 1u : 0u; mine = (j == x) ? c : mine; }
        if (sum == G) break;
        __builtin_amdgcn_s_sleep(1);
        if ((++sp & 255u) == 0u) { if (xb_ld(&bar[XB_TMO])) break; if (sp > XB_SPIN_CAP) { atomicAdd(&bar[XB_TMO], 1u); break; } }
    }
    nloc = mine > 0u ? mine : 1u; nx = cnt > 0u ? cnt : 1u;
}
__device__ __forceinline__ void xcd_barrier(unsigned* bar, volatile LAS unsigned* st, const int wid0) {
    asm volatile("s_waitcnt vmcnt(0)" ::: "memory");
    __syncthreads();
    if (fresh_tid(wid0) == 0) {
        const unsigned x = xb_xcc_id();
        __builtin_amdgcn_s_waitcnt(0);
        unsigned nloc = st[0], nx = st[1];
        if (nloc == 0u) { xcd_barrier_complete(bar, x, nloc, nx); st[0] = nloc; st[1] = nx; }
        const unsigned old = xb_add(&bar[XB_XSUB(x)], 1u);
        const unsigned gen = old / nloc;
        if (old + 1u == (gen + 1u) * nloc) {
            __builtin_amdgcn_fence(__ATOMIC_RELEASE, "agent");
            asm volatile("s_waitcnt vmcnt(0)" ::: "memory");
            const unsigned og = xb_add(&bar[XB_TOP], 1u);
            const unsigned tg = og / nx;
            if (og + 1u == (tg + 1u) * nx) xb_add(&bar[XB_TOPGEN], 1u);
            else XB_SPIN(xb_ld(&bar[XB_TOPGEN]) == tg, bar);
            __builtin_amdgcn_fence(__ATOMIC_ACQUIRE, "agent");
            xb_add(&bar[XB_XGEN(x)], 1u);
            asm volatile("s_waitcnt vmcnt(0)" ::: "memory");
        } else {
            XB_SPIN(xb_ld(&bar[XB_XGEN(x)]) == gen, bar);
            __builtin_amdgcn_fence(__ATOMIC_ACQUIRE, "agent");
            asm volatile("s_waitcnt vmcnt(0)" ::: "memory");
        }
    }
    __syncthreads();
}

struct Params { const void* in[22]; float* out; unsigned char* ws; };

__global__ void __launch_bounds__(NTHR, 2) hybrid_fwd(Params P) {
    extern __shared__ __attribute__((aligned(16))) unsigned char lds_raw[];
    LAS unsigned char* lds = (LAS unsigned char*)lds_raw;
    cg::grid_group grid = cg::this_grid();
    const int wid0 = __builtin_amdgcn_readfirstlane((int)threadIdx.x >> 6); const int wid = wid0;
    int tid, lane;
#define FRESH_TID() do { tid = fresh_tid(wid0); lane = tid & 63; } while (0)
    const int G = gridDim.x, bx = blockIdx.x;
    const int vcu = (G % 8 == 0) ? (bx % 8) * (G / 8) + bx / 8 : bx;
    unsigned char* ws = P.ws;
    unsigned* const xbar = (unsigned*)(ws + WS_BAR); volatile LAS unsigned* const xst = (volatile LAS unsigned*)(lds + MISC_OFF);
    if (fresh_tid(wid0) == 0) { xst[0] = 0u; xst[1] = 0u; (void)xb_add(&xbar[XB_XCNT(xb_xcc_id())], 1u); }
    __syncthreads();
#define GRID_BAR() xcd_barrier(xbar, xst, wid0)
    const float* x = (const float*)P.in[0]; const int* positions = (const int*)P.in[1]; const float* mem = (const float*)P.in[2];
#define WT_IN ((bf16_t*)(ws + WS_WT_IN))
#define WT_CONV ((bf16_t*)(ws + WS_WT_CONV))
#define WT_UQ ((bf16_t*)(ws + WS_WT_UQ))
#define WT_UKV ((bf16_t*)(ws + WS_WT_UKV))
#define WT_MLAO ((bf16_t*)(ws + WS_WT_MLAO))
#define WT_MEMKV ((bf16_t*)(ws + WS_WT_MEMKV))
#define WT_MEMO ((bf16_t*)(ws + WS_WT_MEMO))
#define WT_O ((bf16_t*)(ws + WS_WT_O))
#define COS ((float*)(ws + WS_COS))
#define SIN ((float*)(ws + WS_SIN))
#define MEMN ((bf16_t*)(ws + WS_MEMN))
#define MEMKV ((bf16_t*)(ws + WS_MEMKV))
#define VTM ((bf16_t*)(ws + WS_VTM))
#define KR ((float*)(ws + WS_KR))
#define KROPE ((bf16_t*)(ws + WS_KROPE))
#define SSQ ((float*)(ws + WS_SSQ))
#define H ((bf16_t*)(ws + WS_H))
#define CU ((bf16_t*)(ws + WS_CU))
#define BZ ((bf16_t*)(ws + WS_BZ))
#define CQ ((bf16_t*)(ws + WS_CQ))
#define CKV ((bf16_t*)(ws + WS_CKV))
#define VT ((bf16_t*)(ws + WS_VT))
#define MEMQ ((bf16_t*)(ws + WS_MEMQ))
#define MEMZS ((bf16_t*)(ws + WS_MEMZS))
#define MLAZS ((bf16_t*)(ws + WS_MLAZS))
#define GATES ((bf16_t*)(ws + WS_GATES))
#define QRAW ((bf16_t*)(ws + WS_QRAW))
#define MERGED ((bf16_t*)(ws + WS_MERGED))
#define CONVA ((bf16_t*)(ws + WS_CONVA))
#define MEMY ((bf16_t*)(ws + WS_MEMY))
#ifdef DUP_P0
    for (int rep = 0; rep < 2; ++rep)
#endif
    {
        auto item_desc = [&](int it, const float*& W, int& Nsrc, int& K, int& ns0, int& nd0, int& k0, bf16_t*& Wt, const float*& gk) __attribute__((always_inline)) {
            int r = it; gk = nullptr;
            if (r < 3904) { W = (const float*)P.in[4]; Nsrc = NIN_SRC; K = 2048; Wt = WT_IN; const int kt = r & 15, nt = r >> 4; k0 = kt * 128; nd0 = nt * 64;
                if (nd0 < 4096) ns0 = ((nd0 & 255) >> 6) * 1024 + (nd0 >> 8) * 64;
                else if (nd0 < 5120) ns0 = nd0;
                else if (nd0 < 5376) ns0 = (nd0 == 5120) ? 5120 : -1;
                else ns0 = nd0 - 192;
            } else { r -= 3904; int nkt;
                if (r < 256)                 { W = (const float*)P.in[6];  Nsrc = 2048; K = 1024; Wt = WT_CONV;  nkt = 8; }
                else if ((r -= 256) < 192)   { W = (const float*)P.in[8];  Nsrc = 3072; K = 512;  Wt = WT_UQ;    nkt = 4; gk = (const float*)P.in[7]; }
                else if ((r -= 192) < 256)   { W = (const float*)P.in[10]; Nsrc = 4096; K = 512;  Wt = WT_UKV;   nkt = 4; gk = (const float*)P.in[9]; }
                else if ((r -= 256) < 512)   { W = (const float*)P.in[15]; Nsrc = 2048; K = 2048; Wt = WT_MLAO;  nkt = 16; }
                else if ((r -= 512) < 512)   { W = (const float*)P.in[17]; Nsrc = 2048; K = 2048; Wt = WT_MEMKV; nkt = 16; }
                else if ((r -= 512) < 256)   { W = (const float*)P.in[20]; Nsrc = 2048; K = 1024; Wt = WT_MEMO;  nkt = 8; }
                else { r -= 256;               W = (const float*)P.in[21]; Nsrc = 2048; K = 2048; Wt = WT_O;     nkt = 16; }
                k0 = (r % nkt) * 128; nd0 = (r / nkt) * 64; ns0 = nd0;
            }
        };
        for (int it0 = bx; it0 < 6400; it0 += 4 * G) {
            FRESH_TID();
            f32x4 v[4][4];
#pragma unroll
            for (int j = 0; j < 4; ++j) { const int it = it0 + j * G;
                if (it < 6400) { const float* W; int Nsrc, K, ns0, nd0, k0; bf16_t* Wt; const float* gk; item_desc(it, W, Nsrc, K, ns0, nd0, k0, Wt, gk);
                    if (ns0 >= 0) {
#pragma unroll
                        for (int p = 0; p < 4; ++p) { const int kk = p * 32 + (tid >> 4), n4 = (tid & 15) * 4;
                            v[j][p] = *(const f32x4*)(W + (size_t)(k0 + kk) * Nsrc + ns0 + n4);
                            if (gk) v[j][p] = v[j][p] * gk[k0 + kk]; } } } }
#pragma unroll
            for (int j = 0; j < 4; ++j) { const int it = it0 + j * G;
                if (it < 6400) { const float* W; int Nsrc, K, ns0, nd0, k0; bf16_t* Wt; const float* gk; item_desc(it, W, Nsrc, K, ns0, nd0, k0, Wt, gk);
                    if (ns0 >= 0) { LAS bf16_t* T = (LAS bf16_t*)lds + j * (64 * 136);
#pragma unroll
                        for (int p = 0; p < 4; ++p) { const int kk = p * 32 + (tid >> 4), n4 = (tid & 15) * 4;
                            const unsigned a = pk(v[j][p][0], v[j][p][1]), c = pk(v[j][p][2], v[j][p][3]);
                            T[(n4 + 0) * 136 + kk] = (bf16_t)(a & 0xffffu); T[(n4 + 1) * 136 + kk] = (bf16_t)(a >> 16);
                            T[(n4 + 2) * 136 + kk] = (bf16_t)(c & 0xffffu); T[(n4 + 3) * 136 + kk] = (bf16_t)(c >> 16); } } } }
            __syncthreads();
#pragma unroll
            for (int j = 0; j < 4; ++j) { const int it = it0 + j * G;
                if (it < 6400) { const float* W; int Nsrc, K, ns0, nd0, k0; bf16_t* Wt; const float* gk; item_desc(it, W, Nsrc, K, ns0, nd0, k0, Wt, gk);
                    const LAS bf16_t* T = (const LAS bf16_t*)lds + j * (64 * 136);
#pragma unroll
                    for (int p = 0; p < 2; ++p) { const int n = p * 32 + (tid >> 4), c = tid & 15;
                        u32x4 o = (u32x4){0u, 0u, 0u, 0u};
                        if (ns0 >= 0) o = *(const LAS u32x4*)(T + n * 136 + c * 8);
                        *(u32x4*)(Wt + (size_t)(nd0 + n) * K + k0 + c * 8) = o; } } }
            __syncthreads();
        }
        FRESH_TID();
        const int gw = bx * 8 + wid, NGW = G * 8;
        for (int m = gw; m < NBATCH * TB; m += 2 * NGW) {
            if (m + NGW < NBATCH * TB) rms_row2(x + (size_t)m * DM, x + (size_t)(m + NGW) * DM, (const float*)P.in[3], H + (size_t)m * DM, H + (size_t)(m + NGW) * DM, lane);
            else rms_row(x + (size_t)m * DM, (const float*)P.in[3], H + (size_t)m * DM, lane); }
        for (int m = gw; m < 512; m += NGW) rms_row(mem + (size_t)m * DM, (const float*)P.in[16], MEMN + (size_t)m * DM, lane);
        for (int e = bx * NTHR + tid; e < NBATCH * TB * 32; e += G * NTHR) {
            const int tok = e >> 5, i = e & 31; const double rev = (double)positions[tok] * kInvFreqRev[i]; const float f = (float)(rev - rint(rev));
            COS[e] = __builtin_amdgcn_cosf(f); SIN[e] = __builtin_amdgcn_sinf(f);
        }
    }
    if (P.ws == nullptr) grid.sync();
    GRID_BAR();

    for (int b = 0; b < NBATCH; ++b) {
        bf16_t* KN = (bf16_t*)(P.out + (size_t)b * TB * DM);
        bf16_t* MLAY = KN + (size_t)TB * 2048;
        {
            pg8::Gemm g{H + (size_t)b * TB * DM, WT_IN, TB, NIN, DM}; pg8::StaticOrder S; S.init(TB, NIN, G, bx);
            Epi1 E{CU, BZ, CQ, CKV, MLAZS, MEMQ, MEMZS, GATES, KR, SSQ};
#ifdef DUP_P1
#pragma nounroll
            for (int rep = 0; rep < 2; ++rep)
#endif
            pg8::gemm_phase<Epi1, pg8::StaticOrder, true, true>(lds, g, S, E, wid0);
            if (b == 0) {
                pg8::Gemm g2{MEMN, WT_MEMKV, 512, 2048, DM}; pg8::StaticOrder S2; S2.init(512, 2048, G, (bx + G - ((TB / 256) * (NIN / 256)) % G) % G);
                EpiRowScale E2{MEMKV, 2048, nullptr, 0.f};
                pg8::gemm_phase<EpiRowScale, pg8::StaticOrder, true, true>(lds, g2, S2, E2, wid0);
            }
        }
        GRID_BAR();
        {
            FRESH_TID();
            { pg8::Gemm g{CQ, WT_UQ, TB, 3072, 512, CKV, WT_UKV}; pg8::DualOrder S; S.a.init(TB, 3072, G, bx); S.b.init(TB, 4096, G, bx);
              EpiQKV E{EpiRowScale{QRAW, 3072, SSQ, 1.f / 512.f}, EpiKV{KN, VT, SSQ + (size_t)TB * 8, (const float*)P.in[13], (LAS float*)(lds + XCH_OFF)}};
              pg8::gemm_phase<EpiQKV, pg8::DualOrder, true, true>(lds, g, S, E, wid0); }
            const float* cw = (const float*)P.in[5];
            const int cv_lo = (G == 256) ? (bx < 128 ? bx * 4 : 512 + (bx - 128) * 12) : bx, cv_n = (G == 256) ? (bx < 128 ? 4 : 12) : (TB / 4 - bx + G - 1) / G, cv_st = (G == 256) ? 1 : G;
            for (int ii = 0; ii < cv_n; ++ii) { const int it = cv_lo + ii * cv_st;
                const int t = it * 4 + (tid >> 7), c8 = (tid & 127) * 8;
                const u32x4 zero = (u32x4){0u, 0u, 0u, 0u};
                const u32x4 a2 = *(const u32x4*)(CU + (size_t)t * 1024 + c8);
                const u32x4 a1 = (t >= 1) ? *(const u32x4*)(CU + (size_t)(t - 1) * 1024 + c8) : zero;
                const u32x4 a0 = (t >= 2) ? *(const u32x4*)(CU + (size_t)(t - 2) * 1024 + c8) : zero;
                const u32x4 bb = *(const u32x4*)(BZ + (size_t)t * 1024 + c8);
                float w0[8], w1[8], w2[8];
#pragma unroll
                for (int e = 0; e < 8; ++e) { w0[e] = cw[c8 + e]; w1[e] = cw[1024 + c8 + e]; w2[e] = cw[2048 + c8 + e]; }
                u32x4 o;
#pragma unroll
                for (int e = 0; e < 4; ++e) {
                    const float lo = bf_lo(bb[e]) * (w0[2 * e] * bf_lo(a0[e]) + w1[2 * e] * bf_lo(a1[e]) + w2[2 * e] * bf_lo(a2[e]));
                    const float hh = bf_hi(bb[e]) * (w0[2 * e + 1] * bf_hi(a0[e]) + w1[2 * e + 1] * bf_hi(a1[e]) + w2[2 * e + 1] * bf_hi(a2[e]));
                    o[e] = pk(lo, hh); }
                *(u32x4*)(CONVA + (size_t)t * 1024 + c8) = o;
            }
            const int bxr = (G == 256) ? (bx + 128) % 256 : bx;
            for (int ps = bxr; ps < TB / 64; ps += G) {
                const int t = ps * 64 + (tid >> 3), sub = tid & 7; const float* gk = (const float*)P.in[14];
                const f32x4 xa = *(const f32x4*)(KR + (size_t)t * 64 + sub * 8), xb = *(const f32x4*)(KR + (size_t)t * 64 + sub * 8 + 4);
                float s = (xa[0] * xa[0] + xa[1] * xa[1]) + (xa[2] * xa[2] + xa[3] * xa[3]) + (xb[0] * xb[0] + xb[1] * xb[1]) + (xb[2] * xb[2] + xb[3] * xb[3]);
                s += shx(s, 1, lane); s += shx(s, 2, lane); s += shx(s, 4, lane);
                const float rs = __builtin_amdgcn_rsqf(s * (1.f / 64.f) + EPS);
                float y[8];
#pragma unroll
                for (int e = 0; e < 8; ++e) {
                    const float xn = ((e < 4) ? xa[e & 3] : xb[e & 3]) * rs * gk[sub * 8 + e];
                    const float pr = shx(xn, 4, lane);
                    const int i = (sub & 3) * 8 + e; const float c = COS[(size_t)(b * TB + t) * 32 + i], sn = SIN[(size_t)(b * TB + t) * 32 + i];
                    y[e] = (sub < 4) ? (xn * c - pr * sn) : (xn * c + pr * sn); }
                u32x4 o; o.x = pk(y[0], y[1]); o.y = pk(y[2], y[3]); o.z = pk(y[4], y[5]); o.w = pk(y[6], y[7]);
                *(u32x4*)(KROPE + (size_t)t * 64 + sub * 8) = o;
            }
            if (b == 0) {
                for (int ps = bxr; ps < 64; ps += G) { const int pi = ps * 32 + (tid >> 4), m = pi >> 2, h = pi & 3;
                    norm_row16<256>(MEMKV + (size_t)m * 2048 + h * 256, (const float*)P.in[19], tid & 15, lane); }
                for (int it = (G == 256) ? (bx + 64) % 256 : bx; it < 64; it += G) { const int kt = it & 3, half = (it >> 2) & 1, h = (it >> 3) & 3, bb = it >> 5;
                    vt_item(lds, MEMKV + (size_t)(bb * 256 + kt * 64) * 2048 + 1024 + h * 256 + half * 128, 2048, VTM + (size_t)it * 9216, wid0); }
            }
        }
        GRID_BAR();
        {
#ifdef DUP_ATTN
            for (int rep = 0; rep < 2; ++rep)
#endif
            for (int u = vcu; u < 256; u += G) { const int h = u >> 4, s = u & 15;
#pragma unroll 1
                for (int k = 0; k < 2; ++k) { const int qb = k ? s : 31 - s;
                    attn_unit2<192, true>(lds, QRAW + (size_t)(qb * 256) * 3072 + h * 192, 3072, (const float*)P.in[11], (const float*)P.in[12],
                                         COS + (size_t)(b * TB + qb * 256) * 32, SIN + (size_t)(b * TB + qb * 256) * 32, 0.07216878364870323f * LOG2E,
                                         KN + h * 128, 2048, KROPE, VT + (size_t)(h * 128) * 9216, 4 * qb + 4, 4 * qb,
                                         MLAZS + (size_t)(qb * 256) * 2048 + h * 128, MLAY + (size_t)(qb * 256) * 2048 + h * 128, 2048, wid0); }
            }
            for (int u = bx; u < 256; u += G) { const int half = u & 1, h = (u >> 1) & 3, qb = u >> 3;
                attn_unit<256, false>(lds, MEMQ + (size_t)(qb * 256) * 1024 + h * 256, 1024, (const float*)P.in[18], nullptr, nullptr, nullptr, 0.0625f * LOG2E,
                                      MEMKV + (size_t)(b * 256) * 2048 + h * 256, 2048, nullptr, VTM + (size_t)(((b * 4 + h) * 2 + half) * 4) * 9216, 4, 3,
                                      MEMZS + (size_t)(qb * 256) * 1024 + h * 256 + half * 128, MEMY + (size_t)(qb * 256) * 1024 + h * 256 + half * 128, 1024, wid0); }
        }
        GRID_BAR();
        {
            pg8::StaticOrder S; S.init(TB, 2048, G, bx);
            { pg8::Gemm g{CONVA, WT_CONV, TB, 2048, 1024, MEMY, WT_MEMO}; pg8::DualOrder S2; S2.a = S; S2.b = S;
              EpiGate2 E{EpiGate{GATES, MERGED, 1}, EpiGate{GATES + (size_t)2 * TB * 2048, MERGED, 0}};
              pg8::gemm_phase<EpiGate2, pg8::DualOrder, true, true>(lds, g, S2, E, wid0); }
            { pg8::Gemm g{MLAY, WT_MLAO, TB, 2048, 2048}; EpiGate E{GATES + (size_t)TB * 2048, MERGED, 0};
              pg8::gemm_phase<EpiGate, pg8::StaticOrder, true, true>(lds, g, S, E, wid0); }
        }
        GRID_BAR();
        {
            pg8::Gemm g{MERGED, WT_O, TB, 2048, 2048}; pg8::StaticOrder S; S.init(TB, 2048, G, bx);
            EpiOut E{x + (size_t)b * TB * DM, P.out + (size_t)b * TB * DM};
            pg8::gemm_phase<EpiOut, pg8::StaticOrder, true, true>(lds, g, S, E, wid0);
        }
    }
}

extern "C" void kernel_launch(void* const* d_in, const int* in_sizes, int n_in, void* d_out, int out_size, void* d_ws, size_t ws_size, hipStream_t stream) {
    static int grid_blocks = 0;
    if (grid_blocks == 0) {
        if (n_in != 22 || ws_size < WS_END) { fprintf(stderr, "kernel_launch: unexpected n_in %d / ws_size %zu\n", n_in, ws_size); grid_blocks = -1; return; }
        int dev = 0, cus = 0, per_cu = 0;
        hipGetDevice(&dev);
        hipDeviceGetAttribute(&cus, hipDeviceAttributeMultiprocessorCount, dev);
        hipFuncSetAttribute((const void*)hybrid_fwd, hipFuncAttributeMaxDynamicSharedMemorySize, LDS_BYTES);
        hipOccupancyMaxActiveBlocksPerMultiprocessor(&per_cu, (const void*)hybrid_fwd, NTHR, LDS_BYTES);
        if (per_cu < 1) per_cu = 1;
        grid_blocks = cus * per_cu;
        (void)hipGetLastError();
    }
    if (grid_blocks < 0) return;
    if (hipMemsetAsync((char*)d_ws + WS_BAR, 0, 16384, stream) != hipSuccess) { fprintf(stderr, "kernel_launch: memset of barrier words failed\n"); return; }
    Params p{};
    for (int i = 0; i < 22; ++i) p.in[i] = d_in[i];
    p.out = (float*)d_out; p.ws = (unsigned char*)d_ws;
    void* args[] = {&p};
    hipError_t e = hipLaunchCooperativeKernel((const void*)hybrid_fwd, dim3(grid_blocks), dim3(NTHR), args, LDS_BYTES, stream);
    if (e != hipSuccess) fprintf(stderr, "cooperative launch failed: %s (grid %d)\n", hipGetErrorString(e), grid_blocks);
}
```

```cpp
#include <hip/hip_runtime.h>
#include <hip/hip_cooperative_groups.h>
#include <cstdio>
#include <cstdint>
namespace cg = cooperative_groups;
namespace pg8 {
#define PG8_LAS __attribute__((address_space(3)))
typedef unsigned short bf16_t;
typedef short bf16x8 __attribute__((ext_vector_type(8)));
typedef float f32x4 __attribute__((ext_vector_type(4)));
typedef unsigned u32x4 __attribute__((ext_vector_type(4)));
constexpr int BM = 256, BK = 64, HALF = 128, HTB = HALF * BK * 2  , STAGE_BYTES = 8 * HTB, NXCD = 8, WGM = 8;

__host__ __device__ __forceinline__ int lds_byte(int r, int c) { const int st = (r >> 4) * 2 + (c >> 5), rr = r & 15, cc = c & 31, ob = rr * 64 + cc * 2; return st * 1024 + (ob ^ (((ob >> 9) & 1) << 5)); }
__host__ __device__ __forceinline__ void stage_rc(int b, int& R, int& C) { const int st = b / 1024, sb = b % 1024, swz = sb ^ (((sb >> 9) & 1) << 5); R = (st >> 1) * 16 + swz / 64; C = (st & 1) * 32 + (swz % 64) / 2; }
__host__ __device__ __forceinline__ int perm32(int rho) { const int n = rho >> 4, i = rho & 15; return 8 * (i >> 2) + 4 * n + (i & 3); }

struct Unit { int pm, pn, job; };
struct Gemm { const bf16_t* A; const bf16_t* Bt; int M, N, K; const bf16_t* A2 = nullptr; const bf16_t* Bt2 = nullptr; };

struct StaticOrder {
    int nM, nN, nwg, G, c;
    __host__ __device__ void init(int M, int N, int G_, int c_) { nM = M / BM; nN = N / BM; nwg = nM * nN; G = G_; c = c_; }
    __host__ __device__ bool next(int i, Unit& u) const { const long L = (long)i * G + c; if (L >= nwg) return false; map((int)L, u); u.job = 0; return true; }
    __host__ __device__ void map(int wgid, Unit& u) const {
        { const int q = nwg / NXCD, r = nwg % NXCD, xcd = wgid % NXCD, off = wgid / NXCD; wgid = (xcd < r ? xcd * (q + 1) : r * (q + 1) + (xcd - r) * q) + off; }
        const int nig = WGM * nN, gid = wgid / nig, fm = gid * WGM, gsz = (nM - fm) < WGM ? (nM - fm) : WGM;
        u.pm = fm + ((wgid % nig) % gsz); u.pn = (wgid % nig) / gsz;
    }
    __device__ __forceinline__ void a_ready(const Unit&) const {}
    __device__ __forceinline__ void done(const Unit&) const {}
};

struct DualOrder {
    StaticOrder a, b;
    __host__ __device__ bool next(int i, Unit& u) const { const long L = (long)i * a.G + a.c; if (L < a.nwg) { a.map((int)L, u); u.job = 0; return true; } if (L - a.nwg >= b.nwg) return false; b.map((int)(L - a.nwg), u); u.job = 1; return true; }
    __device__ __forceinline__ void a_ready(const Unit&) const {}
    __device__ __forceinline__ void done(const Unit&) const {}
};

__device__ __forceinline__ unsigned cvt_pk_bf16(float lo, float hi) { unsigned r; asm volatile("v_cvt_pk_bf16_f32 %0, %1, %2" : "=v"(r) : "v"(lo), "v"(hi)); return r; }
template <class Epi, class Sched, bool ALIGN_EPI = false, bool SP2 = false>
__device__ __forceinline__ void gemm_phase(PG8_LAS unsigned char* lds, const Gemm g, const Sched& S, const Epi& E, const int wid0) {
    int tid_l; asm volatile("v_mbcnt_lo_u32_b32 %0, -1, 0\n\tv_mbcnt_hi_u32_b32 %0, -1, %0" : "=v"(tid_l)); tid_l += wid0 * 64;
    const int tid = tid_l, wid = __builtin_amdgcn_readfirstlane(tid >> 6), lane = tid & 63, wr = wid >> 2, wc = wid & 3, fr = lane & 15, fq = lane >> 4;
    const int K = g.K, nt = K / BK;
    unsigned voffA[2], voffB[2];
#pragma unroll
    for (int i = 0; i < 2; ++i) { int R, C; stage_rc(tid * 16 + i * 8192, R, C); const int Rb = Epi::PERM ? ((R & ~31) + perm32(R & 31)) : R;
        voffA[i] = (unsigned)(R * K + C) * 2u; voffB[i] = (unsigned)(Rb * K + C) * 2u; }
    const size_t kstep = (size_t)(BK * 2);
    const size_t hstep = (size_t)HALF * K * 2;
    const size_t tstep = 2 * hstep;
    const unsigned ldsw = (unsigned)wid * 1024u;
    const int aoff = lds_byte(wr * 64 + fr, fq * 8), boff = lds_byte(wc * 32 + fr, fq * 8);
#define PG8_SA(b, h) (((b) * 2 + (h)) * HTB)
#define PG8_SB(b, h) ((4 + (b) * 2 + (h)) * HTB)
#define PG8_STAGE(bufoff, gbase, voff) do { _Pragma("unroll") for (int _i = 0; _i < 2; ++_i) \
        __builtin_amdgcn_global_load_lds((const unsigned*)((const char*)(gbase) + (voff)[_i]), (PG8_LAS unsigned*)(lds + (bufoff) + ldsw + _i * 8192), 16, 0, 0); } while (0)
#define PG8_LDA(dst, b, h) do { _Pragma("unroll") for (int m = 0; m < 4; ++m) _Pragma("unroll") for (int k = 0; k < 2; ++k) dst[m][k] = *(const PG8_LAS bf16x8*)(lds + PG8_SA(b, h) + aoff + m * 2048 + k * 1024); } while (0)
#define PG8_LDB(dst, b, h) do { _Pragma("unroll") for (int n = 0; n < 2; ++n) _Pragma("unroll") for (int k = 0; k < 2; ++k) dst[n][k] = *(const PG8_LAS bf16x8*)(lds + PG8_SB(b, h) + boff + n * 2048 + k * 1024); } while (0)
#define PG8_MMA(ai, bj, At, Bt) do { __builtin_amdgcn_s_setprio(1); _Pragma("unroll") for (int m = 0; m < 4; ++m) _Pragma("unroll") for (int n = 0; n < 2; ++n) _Pragma("unroll") for (int k = 0; k < 2; ++k) \
        acc[ai][bj][m][n] = __builtin_amdgcn_mfma_f32_16x16x32_bf16(Bt[n][k], At[m][k], acc[ai][bj][m][n], 0, 0, 0); __builtin_amdgcn_s_setprio(0); } while (0)
#define PG8_WAIT_V(n) asm volatile("s_waitcnt vmcnt(" #n ")" ::: "memory")
#define PG8_WAIT_L(n) asm volatile("s_waitcnt lgkmcnt(" #n ")" ::: "memory")
#define PG8_BAR __builtin_amdgcn_s_barrier()
#define PG8_SCHED __builtin_amdgcn_sched_barrier(0)
    Unit cur, nxt; int ui = 0;
    if (!S.next(0, cur)) return;
    f32x4 acc[2][2][4][2];
#pragma unroll
    for (int a = 0; a < 2; ++a)
#pragma unroll
        for (int b = 0; b < 2; ++b)
#pragma unroll
            for (int m = 0; m < 4; ++m)
#pragma unroll
                for (int n = 0; n < 2; ++n) acc[a][b][m][n] = (f32x4){0.f, 0.f, 0.f, 0.f};
    bf16x8 At[4][2], B0[2][2], B1[2][2];
    const char* cA = (const char*)(cur.job ? g.A2 : g.A) + (size_t)cur.pm * tstep; const char* cB = (const char*)(cur.job ? g.Bt2 : g.Bt) + (size_t)cur.pn * tstep;
    S.a_ready(cur);
    if constexpr (SP2) {
        PG8_STAGE(PG8_SB(0, 0), cB, voffB); PG8_STAGE(PG8_SB(0, 1), cB + hstep, voffB); PG8_STAGE(PG8_SA(0, 0), cA, voffA); PG8_STAGE(PG8_SA(0, 1), cA + hstep, voffA);
        if (wr == 1) PG8_BAR;
        PG8_WAIT_V(2); PG8_BAR;
        PG8_STAGE(PG8_SB(1, 0), cB + kstep, voffB); PG8_STAGE(PG8_SA(1, 0), cA + kstep, voffA); PG8_STAGE(PG8_SB(1, 1), cB + hstep + kstep, voffB);
        PG8_WAIT_V(6); PG8_BAR;
    } else {
        PG8_STAGE(PG8_SB(0, 0), cB, voffB); PG8_STAGE(PG8_SA(0, 0), cA, voffA); PG8_STAGE(PG8_SB(0, 1), cB + hstep, voffB); PG8_STAGE(PG8_SA(0, 1), cA + hstep, voffA);
        if (wr == 1) PG8_BAR;
        PG8_WAIT_V(4); PG8_BAR;
        PG8_STAGE(PG8_SB(1, 0), cB + kstep, voffB); PG8_STAGE(PG8_SA(1, 0), cA + kstep, voffA); PG8_STAGE(PG8_SB(1, 1), cB + hstep + kstep, voffB);
        PG8_WAIT_V(6); PG8_BAR;
    }
    for (;;) {
        const bool has_next = S.next(ui + 1, nxt);
        const char* nA = has_next ? (const char*)(nxt.job ? g.A2 : g.A) + (size_t)nxt.pm * tstep : cA; const char* nB = has_next ? (const char*)(nxt.job ? g.Bt2 : g.Bt) + (size_t)nxt.pn * tstep : cB;
        for (int t = 0; t < nt; t += 2) {
            const bool last = (t == nt - 2);
            const char* a1 = cA + (size_t)(t + 1) * kstep;
            const char* a2 = last ? nA : cA + (size_t)(t + 2) * kstep; const char* b2 = last ? nB : cB + (size_t)(t + 2) * kstep;
            const char* a3 = a2 + kstep; const char* b3 = b2 + kstep;
            if (last && has_next) S.a_ready(nxt);
            if constexpr (SP2) {
            PG8_LDB(B0, 0, 0); PG8_LDB(B1, 0, 1); PG8_SCHED; PG8_LDA(At, 0, 0); PG8_STAGE(PG8_SA(1, 1), a1 + hstep, voffA);
            PG8_WAIT_V(8); PG8_WAIT_L(0); PG8_BAR; PG8_MMA(0, 0, At, B0); PG8_MMA(0, 1, At, B1); PG8_BAR; PG8_SCHED;
            PG8_LDA(At, 0, 1); PG8_STAGE(PG8_SB(0, 0), b2, voffB); PG8_STAGE(PG8_SB(0, 1), b2 + hstep, voffB); PG8_STAGE(PG8_SA(0, 0), a2, voffA);
            PG8_WAIT_V(8); PG8_WAIT_L(0); PG8_BAR; PG8_MMA(1, 0, At, B0); PG8_MMA(1, 1, At, B1); PG8_BAR; PG8_SCHED;
            PG8_LDB(B0, 1, 0); PG8_LDB(B1, 1, 1); PG8_SCHED; PG8_LDA(At, 1, 0); PG8_STAGE(PG8_SA(0, 1), a2 + hstep, voffA);
            PG8_WAIT_V(8); PG8_WAIT_L(0); PG8_BAR; PG8_MMA(0, 0, At, B0); PG8_MMA(0, 1, At, B1); PG8_BAR; PG8_SCHED;
            PG8_LDA(At, 1, 1); PG8_STAGE(PG8_SB(1, 0), b3, voffB); PG8_STAGE(PG8_SB(1, 1), b3 + hstep, voffB); PG8_STAGE(PG8_SA(1, 0), a3, voffA);
            PG8_WAIT_V(8); PG8_WAIT_L(0); PG8_BAR; PG8_MMA(1, 0, At, B0); PG8_MMA(1, 1, At, B1); PG8_BAR; PG8_SCHED;
            } else {
            PG8_LDB(B0, 0, 0); PG8_SCHED; PG8_LDA(At, 0, 0); PG8_STAGE(PG8_SA(1, 1), a1 + hstep, voffA);
            PG8_WAIT_L(8); PG8_BAR; PG8_WAIT_L(0); PG8_MMA(0, 0, At, B0); PG8_BAR; PG8_SCHED;
            PG8_LDB(B1, 0, 1); PG8_STAGE(PG8_SB(0, 0), b2, voffB);
            PG8_BAR; PG8_WAIT_L(0); PG8_MMA(0, 1, At, B1); PG8_BAR;
            PG8_LDA(At, 0, 1); PG8_STAGE(PG8_SA(0, 0), a2, voffA);
            PG8_BAR; PG8_WAIT_L(0); PG8_MMA(1, 0, At, B0); PG8_BAR; PG8_SCHED;
            PG8_STAGE(PG8_SB(0, 1), b2 + hstep, voffB);
            PG8_WAIT_V(6); PG8_BAR; PG8_MMA(1, 1, At, B1); PG8_BAR;
            PG8_LDB(B0, 1, 0); PG8_SCHED; PG8_LDA(At, 1, 0); PG8_STAGE(PG8_SA(0, 1), a2 + hstep, voffA);
            PG8_WAIT_L(8); PG8_BAR; PG8_WAIT_L(0); PG8_MMA(0, 0, At, B0); PG8_BAR; PG8_SCHED;
            PG8_LDB(B1, 1, 1); PG8_STAGE(PG8_SB(1, 0), b3, voffB);
            PG8_BAR; PG8_WAIT_L(0); PG8_MMA(0, 1, At, B1); PG8_BAR;
            PG8_LDA(At, 1, 1); PG8_STAGE(PG8_SA(1, 0), a3, voffA);
            PG8_BAR; PG8_WAIT_L(0); PG8_MMA(1, 0, At, B0); PG8_BAR; PG8_SCHED;
            PG8_STAGE(PG8_SB(1, 1), b3 + hstep, voffB);
            PG8_WAIT_V(6); PG8_BAR; PG8_MMA(1, 1, At, B1); PG8_BAR;
            }
        }
        if constexpr (ALIGN_EPI) { if (wr == 0) PG8_BAR; }
        asm volatile("s_nop 15\n\ts_nop 3" ::: "memory");
        if constexpr (!Epi::AFTER_DRAIN) { E(acc, cur, wr, wc, fr, fq); S.done(cur); }
        if (!has_next) break;
#pragma unroll
        for (int a = 0; a < 2; ++a)
#pragma unroll
            for (int b = 0; b < 2; ++b)
#pragma unroll
                for (int m = 0; m < 4; ++m)
#pragma unroll
                    for (int n = 0; n < 2; ++n) acc[a][b][m][n] = (f32x4){0.f, 0.f, 0.f, 0.f};
        cur = nxt; cA = nA; cB = nB; ++ui;
        if constexpr (ALIGN_EPI) { if (wr == 1) PG8_BAR; }
    }
    PG8_WAIT_V(0);
    if constexpr (!ALIGN_EPI) { if (wr == 0) PG8_BAR; }
    PG8_BAR;
    if constexpr (Epi::AFTER_DRAIN) { E.fused(acc, cur, wr, wc, fr, fq, lds, wid, lane); S.done(cur); }
#undef PG8_SA
#undef PG8_SB
#undef PG8_STAGE
#undef PG8_LDA
#undef PG8_LDB
#undef PG8_MMA
#undef PG8_WAIT_V
#undef PG8_WAIT_L
#undef PG8_BAR
#undef PG8_SCHED
}
}

#define LAS __attribute__((address_space(3)))
typedef unsigned short bf16_t;
typedef short bf16x8 __attribute__((ext_vector_type(8)));
typedef float f32x4 __attribute__((ext_vector_type(4)));
typedef float f32x16 __attribute__((ext_vector_type(16)));
typedef unsigned u32x4 __attribute__((ext_vector_type(4)));
typedef unsigned u32x2 __attribute__((ext_vector_type(2)));

constexpr int TB = 8192, NBATCH = 2, DM = 2048, NIN = 15616, NIN_SRC = 15424, NTHR = 512;
constexpr float EPS = 1e-6f, LOG2E = 1.4426950408889634f;
constexpr size_t MiB = 1u << 20;
constexpr size_t WS_WT_IN = 0, WS_WT_CONV = 61 * MiB, WS_WT_UQ = 65 * MiB, WS_WT_UKV = 68 * MiB, WS_WT_MLAO = 72 * MiB, WS_WT_MEMKV = 80 * MiB, WS_WT_MEMO = 88 * MiB, WS_WT_O = 92 * MiB;
constexpr size_t WS_COS = 100 * MiB, WS_SIN = 102 * MiB, WS_MEMN = 104 * MiB, WS_MEMKV = 106 * MiB, WS_VTM = 108 * MiB, WS_KR = 110 * MiB, WS_KROPE = 112 * MiB, WS_SSQ = 113 * MiB;
constexpr size_t WS_H = 114 * MiB;
constexpr size_t WS_CU = 178 * MiB, WS_BZ = 194 * MiB, WS_CQ = 210 * MiB, WS_CKV = 218 * MiB, WS_VT = 466 * MiB;
constexpr size_t WS_MEMQ = 226 * MiB, WS_MEMZS = 242 * MiB;
constexpr size_t WS_MLAZS = 258 * MiB, WS_GATES = 290 * MiB, WS_QRAW = 386 * MiB, WS_MERGED = 386 * MiB  ;
constexpr size_t WS_CONVA = 434 * MiB, WS_MEMY = 450 * MiB, WS_END = 502 * MiB;
constexpr int XCH_OFF = 131072;
constexpr int MISC_OFF = 139264;
constexpr size_t WS_BAR = 113 * MiB + 512 * 1024;
constexpr int LDS_BYTES = 147456;

static __device__ const double kInvFreqRev[32] = {
    0.15915494309189535, 0.11934937021124886, 0.08949940160889101, 0.06711508300522726, 0.050329212104487035, 0.03774158471741977, 0.0283021958306234, 0.02122365276477766,
    0.015915494309189534, 0.011934937021124886, 0.008949940160889102, 0.006711508300522725, 0.005032921210448704, 0.003774158471741977, 0.00283021958306234, 0.0021223652764777662,
    0.0015915494309189536, 0.0011934937021124885, 0.0008949940160889102, 0.0006711508300522726, 0.0005032921210448703, 0.00037741584717419774, 0.00028302195830623395, 0.0002122365276477766,
    0.00015915494309189535, 0.00011934937021124886, 8.949940160889102e-05, 6.711508300522725e-05, 5.0329212104487035e-05, 3.774158471741978e-05, 2.8302195830623396e-05, 2.122365276477766e-05};

__device__ __forceinline__ int fresh_tid(int wid0) { int l; asm volatile("v_mbcnt_lo_u32_b32 %0, -1, 0\n\tv_mbcnt_hi_u32_b32 %0, -1, %0" : "=v"(l)); return wid0 * 64 + l; }
__device__ __forceinline__ float shx(float v, int m, int lane) { return __int_as_float(__builtin_amdgcn_ds_bpermute((lane ^ m) << 2, __float_as_int(v))); }
__device__ __forceinline__ float bf_lo(unsigned u) { return __uint_as_float(u << 16); }
__device__ __forceinline__ float bf_hi(unsigned u) { return __uint_as_float(u & 0xffff0000u); }
__device__ __forceinline__ unsigned pk(float lo, float hi) { unsigned r; asm("s_nop 0\n\tv_cvt_pk_bf16_f32 %0, %1, %2" : "=v"(r) : "v"(lo), "v"(hi)); return r; }
typedef float f32x2_t __attribute__((ext_vector_type(2))); typedef __bf16 bf16x2_t __attribute__((ext_vector_type(2)));
__device__ __forceinline__ unsigned pkv(float lo, float hi) { const f32x2_t v = {lo, hi}; const bf16x2_t r = __builtin_convertvector(v, bf16x2_t); return __builtin_bit_cast(unsigned, r); }
__device__ __forceinline__ float sigm(float v) { return __builtin_amdgcn_rcpf(1.f + __builtin_amdgcn_exp2f(-LOG2E * v)); }
__device__ __forceinline__ float silu(float v) { return v * sigm(v); }
__device__ __forceinline__ u32x4 pk8(const f32x4& a, const f32x4& b) { u32x4 w; w.x = pk(a[0], a[1]); w.y = pk(a[2], a[3]); w.z = pk(b[0], b[1]); w.w = pk(b[2], b[3]); return w; }

struct Epi1 {
    static constexpr bool PERM = true, AFTER_DRAIN = false;
    bf16_t *cu, *bz, *cq, *ckv, *mlazs, *memq, *memzs, *gates; float *kr, *ssq;
    __device__ __forceinline__ void operator()(const f32x4 (&acc)[2][2][4][2], const pg8::Unit& u, int wr, int wc, int fr, int fq) const {
        const int pn = u.pn; const int row0 = u.pm * 256 + wr * 64 + fr;
        if (pn < 16) {
            const bool first = wc < 2; bf16_t* dst = (first ? cu : bz) + pn * 64 + (wc & 1) * 32 + 8 * fq;
#pragma unroll
            for (int ai = 0; ai < 2; ++ai)
#pragma unroll
                for (int m = 0; m < 4; ++m) {
                    f32x4 v0, v1;
#pragma unroll
                    for (int j = 0; j < 4; ++j) {
                        const float a0 = acc[ai][0][m][0][j], a1 = acc[ai][0][m][1][j], b0 = acc[ai][1][m][0][j], b1 = acc[ai][1][m][1][j];
                        v0[j] = a0 * (first ? b0 : silu(b0)); v1[j] = a1 * (first ? b1 : silu(b1)); }
                    *(u32x4*)(dst + (size_t)(row0 + ai * 128 + m * 16) * 1024) = pk8(v0, v1);
                }
            return;
        }
        if (pn == 20) {
            if (wc < 2) {
#pragma unroll
                for (int ai = 0; ai < 2; ++ai)
#pragma unroll
                    for (int m = 0; m < 4; ++m) { float* p = kr + (size_t)(row0 + ai * 128 + m * 16) * 64 + wc * 32 + 8 * fq;
                        *(f32x4*)p = acc[ai][0][m][0]; *(f32x4*)(p + 4) = acc[ai][0][m][1]; }
            }
            return;
        }
        bf16_t* dst; int ldc, col, act = 0; float* sq = nullptr;
        if (pn < 18)      { dst = cq;    ldc = 512;  col = (pn - 16) * 256; sq = ssq + (pn - 16) * 4 + wc; }
        else if (pn < 20) { dst = ckv;   ldc = 512;  col = (pn - 18) * 256; sq = ssq + (size_t)TB * 8 + (pn - 18) * 4 + wc; }
        else if (pn < 29) { dst = mlazs; ldc = 2048; col = (pn - 21) * 256; act = 1; }
        else if (pn < 33) { dst = memq;  ldc = 1024; col = (pn - 29) * 256; }
        else if (pn < 37) { dst = memzs; ldc = 1024; col = (pn - 33) * 256; act = 1; }
        else { const int g = (pn - 37) >> 3; dst = gates + (size_t)g * TB * 2048; ldc = 2048; col = ((pn - 37) & 7) * 256; act = 2; }
        dst += col + wc * 32 + 8 * fq;
#pragma unroll
        for (int ai = 0; ai < 2; ++ai)
#pragma unroll
            for (int m = 0; m < 4; ++m) {
                const int row = row0 + ai * 128 + m * 16; float s = 0.f;
#pragma unroll
                for (int bj = 0; bj < 2; ++bj) {
                    f32x4 v0 = acc[ai][bj][m][0], v1 = acc[ai][bj][m][1];
                    if (act == 1) {
#pragma unroll
                        for (int j = 0; j < 4; ++j) { v0[j] = silu(v0[j]); v1[j] = silu(v1[j]); }
                    } else if (act == 2) {
#pragma unroll
                        for (int j = 0; j < 4; ++j) { v0[j] = sigm(v0[j]); v1[j] = sigm(v1[j]); }
                    } else {
#pragma unroll
                        for (int j = 0; j < 4; ++j) s += v0[j] * v0[j] + v1[j] * v1[j];
                    }
                    *(u32x4*)(dst + (size_t)row * ldc + bj * 128) = pk8(v0, v1);
                }
                if (sq) { const int ln = fr + 16 * fq; s += shx(s, 16, ln); s += shx(s, 32, ln); if (fq == 0) sq[(size_t)row * 8] = s; }
            }
    }
};
struct EpiRowScale {
    static constexpr bool PERM = true, AFTER_DRAIN = false;
    bf16_t* O; int ldc; const float* ssq; float inv_k;
    __device__ __forceinline__ void operator()(const f32x4 (&acc)[2][2][4][2], const pg8::Unit& u, int wr, int wc, int fr, int fq) const {
        const int row0 = u.pm * 256 + wr * 64 + fr; bf16_t* dst = O + u.pn * 256 + wc * 32 + 8 * fq;
#pragma unroll
        for (int ai = 0; ai < 2; ++ai)
#pragma unroll
            for (int m = 0; m < 4; ++m) {
                const int row = row0 + ai * 128 + m * 16; float rs = 1.f;
                if (ssq) { const f32x4 a = *(const f32x4*)(ssq + (size_t)row * 8), b = *(const f32x4*)(ssq + (size_t)row * 8 + 4);
                    rs = __builtin_amdgcn_rsqf((((a[0] + a[1]) + (a[2] + a[3])) + ((b[0] + b[1]) + (b[2] + b[3]))) * inv_k + EPS); }
#pragma unroll
                for (int bj = 0; bj < 2; ++bj) *(u32x4*)(dst + (size_t)row * ldc + bj * 128) = pk8(acc[ai][bj][m][0] * rs, acc[ai][bj][m][1] * rs);
            }
    }
};
struct EpiKV {
    static constexpr bool PERM = true, AFTER_DRAIN = false;
    bf16_t* Kn; bf16_t* Vt; const float* ssq; const float* gk; LAS float* X;
    __device__ __forceinline__ void operator()(const f32x4 (&acc)[2][2][4][2], const pg8::Unit& u, int wr, int wc, int fr, int fq) const {
        const int h = u.pn; const int row0 = u.pm * 256 + wr * 64 + fr;
        float rsc[2][4];
#pragma unroll
        for (int ai = 0; ai < 2; ++ai)
#pragma unroll
            for (int m = 0; m < 4; ++m) {
                const int row = row0 + ai * 128 + m * 16;
                const f32x4 a = *(const f32x4*)(ssq + (size_t)row * 8), b = *(const f32x4*)(ssq + (size_t)row * 8 + 4);
                rsc[ai][m] = __builtin_amdgcn_rsqf((((a[0] + a[1]) + (a[2] + a[3])) + ((b[0] + b[1]) + (b[2] + b[3]))) * (1.f / 512.f) + EPS);
                float s = 0.f;
#pragma unroll
                for (int j = 0; j < 4; ++j) s += acc[ai][0][m][0][j] * acc[ai][0][m][0][j] + acc[ai][0][m][1][j] * acc[ai][0][m][1][j];
                { const int ln = fr + 16 * fq; s += shx(s, 16, ln); s += shx(s, 32, ln); }
                if (fq == 0) X[(ai * 128 + wr * 64 + m * 16 + fr) * 4 + wc] = s;
            }
        asm volatile("s_waitcnt lgkmcnt(0)" ::: "memory");
        __builtin_amdgcn_s_barrier();
        const f32x4 g0 = *(const f32x4*)(gk + wc * 32 + 8 * fq), g1 = *(const f32x4*)(gk + wc * 32 + 8 * fq + 4);
#pragma unroll
        for (int ai = 0; ai < 2; ++ai)
#pragma unroll
            for (int m = 0; m < 4; ++m) {
                const int row = row0 + ai * 128 + m * 16;
                const f32x4 p = *(const LAS f32x4*)(X + (ai * 128 + wr * 64 + m * 16 + fr) * 4);
                const float tot = (p[0] + p[1]) + (p[2] + p[3]);
                const float rk = __builtin_amdgcn_rsqf(tot * rsc[ai][m] * rsc[ai][m] * (1.f / 128.f) + EPS) * rsc[ai][m];
                *(u32x4*)(Kn + (size_t)row * 2048 + h * 128 + wc * 32 + 8 * fq) = pk8(acc[ai][0][m][0] * rk * g0, acc[ai][0][m][1] * rk * g1);
            }
#pragma unroll
        for (int ai = 0; ai < 2; ++ai) {
            bf16_t* img = Vt + (size_t)(h * 128 + u.pm * 4 + 2 * ai + wr) * 9216 + (wc * 32 + 8 * fq) * 72 + 4 * fr;
#pragma unroll
            for (int n = 0; n < 2; ++n)
#pragma unroll
                for (int j = 0; j < 4; ++j) { u32x2 w;
                    w.x = pk(acc[ai][1][0][n][j] * rsc[ai][0], acc[ai][1][1][n][j] * rsc[ai][1]); w.y = pk(acc[ai][1][2][n][j] * rsc[ai][2], acc[ai][1][3][n][j] * rsc[ai][3]);
                    *(u32x2*)(img + (4 * n + j) * 72) = w; }
        }
    }
};
struct EpiQKV {
    static constexpr bool PERM = true, AFTER_DRAIN = false;
    EpiRowScale q; EpiKV kv;
    __device__ __forceinline__ void operator()(const f32x4 (&acc)[2][2][4][2], const pg8::Unit& u, int wr, int wc, int fr, int fq) const { if (u.job) kv(acc, u, wr, wc, fr, fq); else q(acc, u, wr, wc, fr, fq); }
};
struct EpiGate {
    static constexpr bool PERM = true, AFTER_DRAIN = false;
    const bf16_t* G; bf16_t* Mg; int first;
    __device__ __forceinline__ void operator()(const f32x4 (&acc)[2][2][4][2], const pg8::Unit& u, int wr, int wc, int fr, int fq) const {
        const int row0 = u.pm * 256 + wr * 64 + fr; const int col0 = u.pn * 256 + wc * 32 + 8 * fq;
#pragma unroll
        for (int ai = 0; ai < 2; ++ai)
#pragma unroll
            for (int m = 0; m < 4; ++m)
#pragma unroll
                for (int bj = 0; bj < 2; ++bj) {
                    const size_t off = (size_t)(row0 + ai * 128 + m * 16) * 2048 + col0 + bj * 128;
                    const u32x4 g = *(const u32x4*)(G + off);
                    f32x4 v0 = acc[ai][bj][m][0], v1 = acc[ai][bj][m][1];
                    v0[0] *= bf_lo(g.x); v0[1] *= bf_hi(g.x); v0[2] *= bf_lo(g.y); v0[3] *= bf_hi(g.y);
                    v1[0] *= bf_lo(g.z); v1[1] *= bf_hi(g.z); v1[2] *= bf_lo(g.w); v1[3] *= bf_hi(g.w);
                    if (!first) { const u32x4 p = *(const u32x4*)(Mg + off);
                        v0[0] += bf_lo(p.x); v0[1] += bf_hi(p.x); v0[2] += bf_lo(p.y); v0[3] += bf_hi(p.y);
                        v1[0] += bf_lo(p.z); v1[1] += bf_hi(p.z); v1[2] += bf_lo(p.w); v1[3] += bf_hi(p.w); }
                    *(u32x4*)(Mg + off) = pk8(v0, v1);
                }
    }
};
struct EpiGate2 {
    static constexpr bool PERM = true, AFTER_DRAIN = false;
    EpiGate e0, e1;
    __device__ __forceinline__ void operator()(const f32x4 (&acc)[2][2][4][2], const pg8::Unit& u, int wr, int wc, int fr, int fq) const { if (u.job) e1(acc, u, wr, wc, fr, fq); else e0(acc, u, wr, wc, fr, fq); }
};
struct EpiOut {
    static constexpr bool PERM = true, AFTER_DRAIN = false;
    const float* X; float* O;
    __device__ __forceinline__ void operator()(const f32x4 (&acc)[2][2][4][2], const pg8::Unit& u, int wr, int wc, int fr, int fq) const {
        const int row0 = u.pm * 256 + wr * 64 + fr; const int col0 = u.pn * 256 + wc * 32 + 8 * fq;
#pragma unroll
        for (int ai = 0; ai < 2; ++ai)
#pragma unroll
            for (int m = 0; m < 4; ++m)
#pragma unroll
                for (int bj = 0; bj < 2; ++bj) {
                    const size_t off = (size_t)(row0 + ai * 128 + m * 16) * 2048 + col0 + bj * 128;
                    const f32x4 x0 = *(const f32x4*)(X + off), x1 = *(const f32x4*)(X + off + 4);
                    *(f32x4*)(O + off) = x0 + acc[ai][bj][m][0]; *(f32x4*)(O + off + 4) = x1 + acc[ai][bj][m][1];
                }
    }
};

__device__ __forceinline__ void transpose_tile(LAS unsigned char* lds, const float* W, int Nsrc, int ns0, int K, int k0, bf16_t* Wt, int nd0, const float* gk, const int wid0) {
    const int tid = fresh_tid(wid0); LAS bf16_t* T = (LAS bf16_t*)lds;
    if (ns0 >= 0) {
#pragma unroll
        for (int p = 0; p < 4; ++p) {
            const int kk = p * 32 + (tid >> 4), n4 = (tid & 15) * 4;
            f32x4 v = *(const f32x4*)(W + (size_t)(k0 + kk) * Nsrc + ns0 + n4);
            if (gk) v = v * gk[k0 + kk];
            const unsigned a = pk(v[0], v[1]), b = pk(v[2], v[3]);
            T[(n4 + 0) * 136 + kk] = (bf16_t)(a & 0xffffu); T[(n4 + 1) * 136 + kk] = (bf16_t)(a >> 16);
            T[(n4 + 2) * 136 + kk] = (bf16_t)(b & 0xffffu); T[(n4 + 3) * 136 + kk] = (bf16_t)(b >> 16);
        }
    }
    __syncthreads();
#pragma unroll
    for (int p = 0; p < 2; ++p) {
        const int n = p * 32 + (tid >> 4), c = tid & 15;
        u32x4 o = (u32x4){0u, 0u, 0u, 0u};
        if (ns0 >= 0) o = *(const LAS u32x4*)(T + n * 136 + c * 8);
        *(u32x4*)(Wt + (size_t)(nd0 + n) * K + k0 + c * 8) = o;
    }
    __syncthreads();
}
__device__ __forceinline__ float wave_sum(float v, int lane) {
#pragma unroll
    for (int o = 1; o < 64; o <<= 1) v += shx(v, o, lane);
    return v;
}
__device__ __forceinline__ void rms_row(const float* xrow, const float* g, bf16_t* orow, int lane) {
    const f32x4* xr = (const f32x4*)xrow + lane; const f32x4* gr = (const f32x4*)g + lane;
    f32x4 v[8]; float s = 0.f;
#pragma unroll
    for (int j = 0; j < 8; ++j) { v[j] = xr[64 * j]; s += (v[j][0] * v[j][0] + v[j][1] * v[j][1]) + (v[j][2] * v[j][2] + v[j][3] * v[j][3]); }
    const float rs = __builtin_amdgcn_rsqf(wave_sum(s, lane) * (1.f / 2048.f) + EPS);
    u32x2* o8 = (u32x2*)orow + lane;
#pragma unroll
    for (int j = 0; j < 8; ++j) { const f32x4 gg = gr[64 * j]; u32x2 w; w.x = pk(v[j][0] * rs * gg[0], v[j][1] * rs * gg[1]); w.y = pk(v[j][2] * rs * gg[2], v[j][3] * rs * gg[3]); o8[64 * j] = w; }
}
__device__ __forceinline__ void rms_row2(const float* xa, const float* xb, const float* g, bf16_t* oa, bf16_t* ob, int lane) {
    const f32x4* pa = (const f32x4*)xa + lane; const f32x4* pb = (const f32x4*)xb + lane; const f32x4* gr = (const f32x4*)g + lane;
    f32x4 va[8], vb[8]; float sa = 0.f, sb = 0.f;
#pragma unroll
    for (int j = 0; j < 8; ++j) { va[j] = pa[64 * j]; vb[j] = pb[64 * j]; }
#pragma unroll
    for (int j = 0; j < 8; ++j) { sa += (va[j][0] * va[j][0] + va[j][1] * va[j][1]) + (va[j][2] * va[j][2] + va[j][3] * va[j][3]); sb += (vb[j][0] * vb[j][0] + vb[j][1] * vb[j][1]) + (vb[j][2] * vb[j][2] + vb[j][3] * vb[j][3]); }
    const float ra = __builtin_amdgcn_rsqf(wave_sum(sa, lane) * (1.f / 2048.f) + EPS), rb = __builtin_amdgcn_rsqf(wave_sum(sb, lane) * (1.f / 2048.f) + EPS);
    u32x2* qa = (u32x2*)oa + lane; u32x2* qb = (u32x2*)ob + lane;
#pragma unroll
    for (int j = 0; j < 8; ++j) { const f32x4 gg = gr[64 * j]; u32x2 w;
        w.x = pk(va[j][0] * ra * gg[0], va[j][1] * ra * gg[1]); w.y = pk(va[j][2] * ra * gg[2], va[j][3] * ra * gg[3]); qa[64 * j] = w;
        w.x = pk(vb[j][0] * rb * gg[0], vb[j][1] * rb * gg[1]); w.y = pk(vb[j][2] * rb * gg[2], vb[j][3] * rb * gg[3]); qb[64 * j] = w; }
}
__device__ __forceinline__ void vt_item(LAS unsigned char* lds, const bf16_t* src, int pitch, bf16_t* dst, const int wid0) {
    const int tid = fresh_tid(wid0); LAS bf16_t* T = (LAS bf16_t*)lds;
#pragma unroll
    for (int p = 0; p < 2; ++p) {
        const int c = tid + 512 * p, key = c >> 4, d8 = (c & 15) * 8;
        const u32x4 v = *(const u32x4*)(src + (size_t)key * pitch + d8);
        const int pos = 4 * (key & 15) + (key >> 4);
        T[(d8 + 0) * 72 + pos] = (bf16_t)(v.x & 0xffffu); T[(d8 + 1) * 72 + pos] = (bf16_t)(v.x >> 16);
        T[(d8 + 2) * 72 + pos] = (bf16_t)(v.y & 0xffffu); T[(d8 + 3) * 72 + pos] = (bf16_t)(v.y >> 16);
        T[(d8 + 4) * 72 + pos] = (bf16_t)(v.z & 0xffffu); T[(d8 + 5) * 72 + pos] = (bf16_t)(v.z >> 16);
        T[(d8 + 6) * 72 + pos] = (bf16_t)(v.w & 0xffffu); T[(d8 + 7) * 72 + pos] = (bf16_t)(v.w >> 16);
    }
    __syncthreads();
#pragma unroll
    for (int p = 0; p < 3; ++p) { const int c = tid + 512 * p; if (c < 1152) *(u32x4*)(dst + c * 8) = *(const LAS u32x4*)(T + c * 8); }
    __syncthreads();
}
template <int W> __device__ __forceinline__ void norm_row16(bf16_t* row, const float* g, int sub, int lane) {
    constexpr int NC = W / 128;
    u32x4 r[NC]; float s = 0.f;
#pragma unroll
    for (int c = 0; c < NC; ++c) { r[c] = *(const u32x4*)(row + c * 128 + sub * 8);
#pragma unroll
        for (int e = 0; e < 4; ++e) { const float a = bf_lo(r[c][e]), b = bf_hi(r[c][e]); s += a * a + b * b; } }
    s += shx(s, 1, lane); s += shx(s, 2, lane); s += shx(s, 4, lane); s += shx(s, 8, lane);
    const float rs = __builtin_amdgcn_rsqf(s * (1.f / W) + EPS);
#pragma unroll
    for (int c = 0; c < NC; ++c) { const f32x4 g0 = *(const f32x4*)(g + c * 128 + sub * 8), g1 = *(const f32x4*)(g + c * 128 + sub * 8 + 4); u32x4 o;
        o.x = pk(bf_lo(r[c].x) * rs * g0[0], bf_hi(r[c].x) * rs * g0[1]); o.y = pk(bf_lo(r[c].y) * rs * g0[2], bf_hi(r[c].y) * rs * g0[3]);
        o.z = pk(bf_lo(r[c].z) * rs * g1[0], bf_hi(r[c].z) * rs * g1[1]); o.w = pk(bf_lo(r[c].w) * rs * g1[2], bf_hi(r[c].w) * rs * g1[3]);
        *(u32x4*)(row + c * 128 + sub * 8) = o; }
}

template <int DQK, bool MLA>
__device__ __forceinline__ void attn_unit(LAS unsigned char* lds, const bf16_t* Q, int qpitch, const float* g1, const float* g2, const float* cosT, const float* sinT, float qscale,
                                          const bf16_t* Ka, int kapitch, const bf16_t* Kb, const bf16_t* Vt, int NT, int tmax_off, const bf16_t* Z, bf16_t* O, int opitch, const int wid0) {
    constexpr int KS = DQK / 16, KPITCH = DQK * 2 + 16, KT_BYTES = 64 * KPITCH, VT_BYTES = 18432, CPR = DQK / 8, NKC = (64 * CPR) / NTHR;
    const int tid = fresh_tid(wid0), lane = tid & 63, r32 = lane & 31, hi = lane >> 5; const int wid = wid0;
    const int tmax_w = MLA ? (tmax_off + (wid >> 1)) : tmax_off;
    bf16x8 qf[KS];
    {
        const bf16_t* qrow = Q + (size_t)(wid * 32 + r32) * qpitch + hi * 8;
        u32x4 raw[KS];
#pragma unroll
        for (int d0 = 0; d0 < KS; ++d0) raw[d0] = *(const u32x4*)(qrow + d0 * 16);
        constexpr int NS1 = MLA ? 8 : KS;
        float s1 = 0.f, s2 = 0.f;
#pragma unroll
        for (int d0 = 0; d0 < KS; ++d0)
#pragma unroll
            for (int e = 0; e < 4; ++e) { const float a = bf_lo(raw[d0][e]), b = bf_hi(raw[d0][e]); if (d0 < NS1) s1 += a * a + b * b; else s2 += a * a + b * b; }
        s1 += shx(s1, 32, lane); s2 += shx(s2, 32, lane);
        const float rs1 = __builtin_amdgcn_rsqf(s1 * (MLA ? (1.f / 128.f) : (1.f / 256.f)) + EPS) * qscale;
#pragma unroll
        for (int d0 = 0; d0 < NS1; ++d0) {
            const f32x4 ga = *(const f32x4*)(g1 + d0 * 16 + hi * 8), gb = *(const f32x4*)(g1 + d0 * 16 + hi * 8 + 4); u32x4 o;
            o.x = pk(bf_lo(raw[d0].x) * rs1 * ga[0], bf_hi(raw[d0].x) * rs1 * ga[1]); o.y = pk(bf_lo(raw[d0].y) * rs1 * ga[2], bf_hi(raw[d0].y) * rs1 * ga[3]);
            o.z = pk(bf_lo(raw[d0].z) * rs1 * gb[0], bf_hi(raw[d0].z) * rs1 * gb[1]); o.w = pk(bf_lo(raw[d0].w) * rs1 * gb[2], bf_hi(raw[d0].w) * rs1 * gb[3]);
            qf[d0] = __builtin_bit_cast(bf16x8, o);
        }
        if constexpr (MLA) {
            const float rs2 = __builtin_amdgcn_rsqf(s2 * (1.f / 64.f) + EPS) * qscale;
            const float* cr = cosT + (size_t)(wid * 32 + r32) * 32; const float* sr = sinT + (size_t)(wid * 32 + r32) * 32;
#pragma unroll
            for (int dd = 0; dd < 2; ++dd) {
                const int i0 = dd * 16 + hi * 8;
                float x1[8], x2[8], y1[8], y2[8];
#pragma unroll
                for (int e = 0; e < 4; ++e) { x1[2 * e] = bf_lo(raw[8 + dd][e]); x1[2 * e + 1] = bf_hi(raw[8 + dd][e]); x2[2 * e] = bf_lo(raw[10 + dd][e]); x2[2 * e + 1] = bf_hi(raw[10 + dd][e]); }
#pragma unroll
                for (int e = 0; e < 8; ++e) {
                    const float a = x1[e] * rs2 * g2[i0 + e], b = x2[e] * rs2 * g2[32 + i0 + e], c = cr[i0 + e], s = sr[i0 + e];
                    y1[e] = a * c - b * s; y2[e] = b * c + a * s; }
                u32x4 o1, o2;
                o1.x = pk(y1[0], y1[1]); o1.y = pk(y1[2], y1[3]); o1.z = pk(y1[4], y1[5]); o1.w = pk(y1[6], y1[7]);
                o2.x = pk(y2[0], y2[1]); o2.y = pk(y2[2], y2[3]); o2.z = pk(y2[4], y2[5]); o2.w = pk(y2[6], y2[7]);
                qf[8 + dd] = __builtin_bit_cast(bf16x8, o1); qf[10 + dd] = __builtin_bit_cast(bf16x8, o2);
            }
        }
    }
    u32x4 kreg[NKC], vreg[3];
    auto load_tile = [&](int t) {
#pragma unroll
        for (int i = 0; i < NKC; ++i) { const int c = tid + NTHR * i, row = c / CPR, cc = c % CPR; const size_t key = (size_t)t * 64 + row;
            const bf16_t* src = (MLA && cc >= 16) ? (Kb + key * 64 + (cc - 16) * 8) : (Ka + key * kapitch + cc * 8);
            kreg[i] = *(const u32x4*)src; }
        const bf16_t* vs = Vt + (size_t)t * 9216;
        vreg[0] = *(const u32x4*)(vs + tid * 8); vreg[1] = *(const u32x4*)(vs + (tid + 512) * 8);
        if (tid < 128) vreg[2] = *(const u32x4*)(vs + (tid + 1024) * 8);
    };
    auto store_tile = [&](int buf) {
        LAS unsigned char* kb = lds + buf * KT_BYTES; LAS unsigned char* vb = lds + 2 * KT_BYTES + buf * VT_BYTES;
#pragma unroll
        for (int i = 0; i < NKC; ++i) { const int c = tid + NTHR * i, key = c / CPR, cc = c % CPR; const int row = ((key & 12) << 2) + ((key & 1) << 3) + ((key & 2) << 1) + (key >> 4);
            *(LAS u32x4*)(kb + row * KPITCH + cc * 16) = kreg[i]; }
        *(LAS u32x4*)(vb + tid * 16) = vreg[0]; *(LAS u32x4*)(vb + (tid + 512) * 16) = vreg[1];
        if (tid < 128) *(LAS u32x4*)(vb + (tid + 1024) * 16) = vreg[2];
    };
    f32x16 o[4];
#pragma unroll
    for (int d = 0; d < 4; ++d)
#pragma unroll
        for (int i = 0; i < 16; ++i) o[d][i] = 0.f;
    float m_run = -1e30f, l_run = 0.f;
    load_tile(0); store_tile(0); __syncthreads();
    for (int t = 0; t < NT; ++t) {
        const bool more = (t + 1 < NT);
        if (more) load_tile(t + 1);
        if (t <= tmax_w) {
            const LAS unsigned char* kb = lds + (t & 1) * KT_BYTES + r32 * KPITCH + hi * 16;
            const LAS unsigned char* vb = lds + 2 * KT_BYTES + (t & 1) * VT_BYTES + r32 * 144 + hi * 16;
            f32x16 p0, p1;
#pragma unroll
            for (int i = 0; i < 16; ++i) { p0[i] = 0.f; p1[i] = 0.f; }
            bf16x8 ka_[3], kb_[3];
            ka_[0] = *(const LAS bf16x8*)(kb); kb_[0] = *(const LAS bf16x8*)(kb + 32 * KPITCH);
            ka_[1] = *(const LAS bf16x8*)(kb + 32); kb_[1] = *(const LAS bf16x8*)(kb + 32 * KPITCH + 32);
            __builtin_amdgcn_sched_barrier(0);
#pragma unroll
            for (int d0 = 0; d0 < KS; ++d0) {
                if (d0 + 2 < KS) { ka_[(d0 + 2) % 3] = *(const LAS bf16x8*)(kb + (d0 + 2) * 32); kb_[(d0 + 2) % 3] = *(const LAS bf16x8*)(kb + 32 * KPITCH + (d0 + 2) * 32); }
                p0 = __builtin_amdgcn_mfma_f32_32x32x16_bf16(ka_[d0 % 3], qf[d0], p0, 0, 0, 0);
                p1 = __builtin_amdgcn_mfma_f32_32x32x16_bf16(kb_[d0 % 3], qf[d0], p1, 0, 0, 0);
                __builtin_amdgcn_sched_barrier(0);
            }
            float mx = fmaxf(p0[0], p1[0]);
#pragma unroll
            for (int i = 1; i < 16; ++i) mx = fmaxf(mx, fmaxf(p0[i], p1[i]));
            mx = fmaxf(mx, shx(mx, 32, lane));
            const float m_new = fmaxf(m_run, mx), alpha = __builtin_amdgcn_exp2f(m_run - m_new);
            m_run = m_new;
            float rsum = 0.f;
#pragma unroll
            for (int i = 0; i < 16; ++i) { p0[i] = __builtin_amdgcn_exp2f(p0[i] - m_new); p1[i] = __builtin_amdgcn_exp2f(p1[i] - m_new); rsum += p0[i] + p1[i]; }
            l_run = l_run * alpha + rsum;
#pragma unroll
            for (int d = 0; d < 4; ++d)
#pragma unroll
                for (int i = 0; i < 16; ++i) o[d][i] *= alpha;
#pragma unroll
            for (int ks = 0; ks < 4; ++ks) {
                u32x4 w;
                if (ks < 2) { const int b = 8 * (ks & 1); w.x = pk(p0[b], p0[b + 1]); w.y = pk(p0[b + 2], p0[b + 3]); w.z = pk(p0[b + 4], p0[b + 5]); w.w = pk(p0[b + 6], p0[b + 7]); }
                else        { const int b = 8 * (ks & 1); w.x = pk(p1[b], p1[b + 1]); w.y = pk(p1[b + 2], p1[b + 3]); w.z = pk(p1[b + 4], p1[b + 5]); w.w = pk(p1[b + 6], p1[b + 7]); }
                const bf16x8 pb = __builtin_bit_cast(bf16x8, w);
#pragma unroll
                for (int d = 0; d < 4; ++d) {
                    const bf16x8 va = *(const LAS bf16x8*)(vb + d * (32 * 144) + ks * 32);
                    o[d] = __builtin_amdgcn_mfma_f32_32x32x16_bf16(va, pb, o[d], 0, 0, 0);
                }
            }
        }
        if (more) store_tile((t + 1) & 1);
        __syncthreads();
    }
    l_run += shx(l_run, 32, lane);
    const float inv = 1.f / l_run;
    const size_t rowoff = (size_t)(wid * 32 + r32) * opitch;
#pragma unroll
    for (int d = 0; d < 4; ++d)
#pragma unroll
        for (int gp = 0; gp < 2; ++gp) {
            const int col = 32 * d + 16 * gp + 8 * hi;
            const u32x4 z = *(const u32x4*)(Z + rowoff + col);
            const auto z0 = __builtin_amdgcn_permlane32_swap(z.x, z.z, false, false), z1 = __builtin_amdgcn_permlane32_swap(z.y, z.w, false, false);
            const int g = 2 * gp;
            unsigned a0 = pkv(o[d][4 * g + 0] * inv * bf_lo(z0[0]), o[d][4 * g + 1] * inv * bf_hi(z0[0]));
            unsigned a1 = pkv(o[d][4 * g + 2] * inv * bf_lo(z1[0]), o[d][4 * g + 3] * inv * bf_hi(z1[0]));
            unsigned b0 = pkv(o[d][4 * g + 4] * inv * bf_lo(z0[1]), o[d][4 * g + 5] * inv * bf_hi(z0[1]));
            unsigned b1 = pkv(o[d][4 * g + 6] * inv * bf_lo(z1[1]), o[d][4 * g + 7] * inv * bf_hi(z1[1]));
            const auto w0 = __builtin_amdgcn_permlane32_swap(a0, b0, false, false), w1 = __builtin_amdgcn_permlane32_swap(a1, b1, false, false);
            u32x4 w; w.x = w0[0]; w.y = w1[0]; w.z = w0[1]; w.w = w1[1];
            *(u32x4*)(O + rowoff + col) = w;
        }
}

template <int DQK, bool MLA>
__device__ __forceinline__ void attn_unit2(LAS unsigned char* lds, const bf16_t* Q, int qpitch, const float* g1, const float* g2, const float* cosT, const float* sinT, float qscale,
                                           const bf16_t* Ka, int kapitch, const bf16_t* Kb, const bf16_t* Vt, int NT, int tmax_off, const bf16_t* Z, bf16_t* O, int opitch, const int wid0) {
    constexpr int KS = DQK / 16, KPITCH = DQK * 2 + 16, KT_BYTES = 64 * KPITCH, VT_BYTES = 18432, CPR = DQK / 8, NKC = (64 * CPR) / NTHR;
    const int tid = fresh_tid(wid0), lane = tid & 63, r32 = lane & 31, hi = lane >> 5; const int wid = wid0;
    const int tmax_w = MLA ? (tmax_off + (wid >> 1)) : tmax_off;
    u32x4 kreg[NKC], vreg[3];
    unsigned ksrc[NKC], kdst[NKC];
#pragma unroll
    for (int i = 0; i < NKC; ++i) {
        int key, cc; bool rope = false;
        if constexpr (MLA) { if (i < 2) { const int c = tid + NTHR * i; key = c >> 4; cc = c & 15; } else { key = tid >> 3; cc = 16 + (tid & 7); rope = true; } }
        else { const int c = tid + NTHR * i; key = c >> 5; cc = c & 31; }
        ksrc[i] = rope ? (unsigned)(key * 128 + (cc - 16) * 16) : (unsigned)(key * kapitch * 2 + cc * 16);
        const int row = ((key & 12) << 2) + ((key & 1) << 3) + ((key & 2) << 1) + (key >> 4);
        kdst[i] = (unsigned)(row * KPITCH + cc * 16);
    }
    auto gload_k = [&](int t) __attribute__((always_inline)) {
        const char* ka = (const char*)(Ka + (size_t)t * 64 * kapitch); const char* kb2 = (const char*)(Kb + (size_t)t * 64 * 64);
#pragma unroll
        for (int i = 0; i < NKC; ++i) kreg[i] = *(const u32x4*)(((MLA && i >= 2) ? kb2 : ka) + ksrc[i]);
    };
    auto gload_v = [&](int t) __attribute__((always_inline)) {
        const char* vs = (const char*)(Vt + (size_t)t * 9216);
        vreg[0] = *(const u32x4*)(vs + (unsigned)tid * 16u); vreg[1] = *(const u32x4*)(vs + (unsigned)tid * 16u + 8192u);
        if (tid < 128) vreg[2] = *(const u32x4*)(vs + (unsigned)tid * 16u + 16384u);
    };
    auto sts_k = [&](int kofs) __attribute__((always_inline)) {
        LAS unsigned char* kb = lds + kofs;
#pragma unroll
        for (int i = 0; i < NKC; ++i) *(LAS u32x4*)(kb + kdst[i]) = kreg[i];
    };
    auto sts_v = [&](int buf) __attribute__((always_inline)) {
        LAS unsigned char* vb = lds + 3 * KT_BYTES + buf * VT_BYTES;
        *(LAS u32x4*)(vb + tid * 16) = vreg[0]; *(LAS u32x4*)(vb + (tid + 512) * 16) = vreg[1];
        if (tid < 128) *(LAS u32x4*)(vb + (tid + 1024) * 16) = vreg[2];
    };
    gload_k(0); gload_v(0);
    u32x4 kreg1[NKC];
    { const char* ka = (const char*)(Ka + (size_t)64 * kapitch); const char* kb2 = (const char*)(Kb + (size_t)64 * 64);
#pragma unroll
      for (int i = 0; i < NKC; ++i) kreg1[i] = *(const u32x4*)(((MLA && i >= 2) ? kb2 : ka) + ksrc[i]); }
    bf16x8 qf[KS];
    {
        const bf16_t* qrow = Q + (size_t)(wid * 32 + r32) * qpitch + hi * 8;
        u32x4 raw[KS];
#pragma unroll
        for (int d0 = 0; d0 < KS; ++d0) raw[d0] = *(const u32x4*)(qrow + d0 * 16);
        constexpr int NS1 = MLA ? 8 : KS;
        float s1 = 0.f, s2 = 0.f;
#pragma unroll
        for (int d0 = 0; d0 < KS; ++d0)
#pragma unroll
            for (int e = 0; e < 4; ++e) { const float a = bf_lo(raw[d0][e]), b = bf_hi(raw[d0][e]); if (d0 < NS1) s1 += a * a + b * b; else s2 += a * a + b * b; }
        s1 += shx(s1, 32, lane); s2 += shx(s2, 32, lane);
        const float rs1 = __builtin_amdgcn_rsqf(s1 * (MLA ? (1.f / 128.f) : (1.f / 256.f)) + EPS) * qscale;
#pragma unroll
        for (int d0 = 0; d0 < NS1; ++d0) {
            const f32x4 ga = *(const f32x4*)(g1 + d0 * 16 + hi * 8), gb = *(const f32x4*)(g1 + d0 * 16 + hi * 8 + 4); u32x4 o;
            o.x = pk(bf_lo(raw[d0].x) * rs1 * ga[0], bf_hi(raw[d0].x) * rs1 * ga[1]); o.y = pk(bf_lo(raw[d0].y) * rs1 * ga[2], bf_hi(raw[d0].y) * rs1 * ga[3]);
            o.z = pk(bf_lo(raw[d0].z) * rs1 * gb[0], bf_hi(raw[d0].z) * rs1 * gb[1]); o.w = pk(bf_lo(raw[d0].w) * rs1 * gb[2], bf_hi(raw[d0].w) * rs1 * gb[3]);
            qf[d0] = __builtin_bit_cast(bf16x8, o);
        }
        if constexpr (MLA) {
            const float rs2 = __builtin_amdgcn_rsqf(s2 * (1.f / 64.f) + EPS) * qscale;
            const float* cr = cosT + (size_t)(wid * 32 + r32) * 32; const float* sr = sinT + (size_t)(wid * 32 + r32) * 32;
#pragma unroll
            for (int dd = 0; dd < 2; ++dd) {
                const int i0 = dd * 16 + hi * 8;
                float x1[8], x2[8], y1[8], y2[8];
#pragma unroll
                for (int e = 0; e < 4; ++e) { x1[2 * e] = bf_lo(raw[8 + dd][e]); x1[2 * e + 1] = bf_hi(raw[8 + dd][e]); x2[2 * e] = bf_lo(raw[10 + dd][e]); x2[2 * e + 1] = bf_hi(raw[10 + dd][e]); }
#pragma unroll
                for (int e = 0; e < 8; ++e) {
                    const float a = x1[e] * rs2 * g2[i0 + e], b = x2[e] * rs2 * g2[32 + i0 + e], c = cr[i0 + e], s = sr[i0 + e];
                    y1[e] = a * c - b * s; y2[e] = b * c + a * s; }
                u32x4 o1, o2;
                o1.x = pk(y1[0], y1[1]); o1.y = pk(y1[2], y1[3]); o1.z = pk(y1[4], y1[5]); o1.w = pk(y1[6], y1[7]);
                o2.x = pk(y2[0], y2[1]); o2.y = pk(y2[2], y2[3]); o2.z = pk(y2[4], y2[5]); o2.w = pk(y2[6], y2[7]);
                qf[8 + dd] = __builtin_bit_cast(bf16x8, o1); qf[10 + dd] = __builtin_bit_cast(bf16x8, o2);
            }
        }
    }
    f32x16 o[4];
#pragma unroll
    for (int d = 0; d < 4; ++d)
#pragma unroll
        for (int i = 0; i < 16; ++i) o[d][i] = 0.f;
    float l_run = 0.f;
    f32x16 sX, sY;
    sts_k(0); sts_v(0);
#pragma unroll
    for (int i = 0; i < NKC; ++i) *(LAS u32x4*)(lds + KT_BYTES + kdst[i]) = kreg1[i];
    __syncthreads();
    {
        const LAS unsigned char* kb = lds + r32 * KPITCH + hi * 16;
#pragma unroll
        for (int i = 0; i < 16; ++i) sX[i] = 0.f;
#pragma unroll
        for (int d0 = 0; d0 < KS; ++d0) sX = __builtin_amdgcn_mfma_f32_32x32x16_bf16(*(const LAS bf16x8*)(kb + d0 * 32), qf[d0], sX, 0, 0, 0);
    }
    __syncthreads();
    bf16x8 kp0, kp1;
    { const LAS unsigned char* kb = lds + 32 * KPITCH + r32 * KPITCH + hi * 16; kp0 = *(const LAS bf16x8*)(kb); kp1 = *(const LAS bf16x8*)(kb + 32); }
    float rs_early = 0.f;
    {
        float s = 0.f;
#pragma unroll
        for (int e = 0; e < 6; ++e) { const float x = __builtin_amdgcn_exp2f(sX[e]); sX[e] = x; s += x; }
        rs_early = s;
    }
    auto substep = [&](f32x16& a, f32x16& b, int knext_ofs, int vofs, int h, int kafter_ofs) __attribute__((always_inline)) {
        const LAS unsigned char* kb = lds + knext_ofs + r32 * KPITCH + hi * 16;
        const LAS unsigned char* vb = lds + vofs + r32 * 144 + hi * 16 + h * 64;
        u32x4 pw0, pw1; bf16x8 vf0[4], vf1[4], kr[3];
        kr[0] = kp0; kr[1] = kp1;
        float rs0 = rs_early;
        __builtin_amdgcn_sched_barrier(0);
#pragma unroll
        for (int d0 = 0; d0 < KS; ++d0) {
            if (d0 + 2 < KS) kr[(d0 + 2) % 3] = *(const LAS bf16x8*)(kb + (d0 + 2) * 32);
            if (d0 == KS - 3) {
#pragma unroll
                for (int d = 0; d < 4; ++d) vf0[d] = *(const LAS bf16x8*)(vb + d * 4608);
            }
            if (d0 == 0) { const f32x16 z16 = {0.f, 0.f, 0.f, 0.f, 0.f, 0.f, 0.f, 0.f, 0.f, 0.f, 0.f, 0.f, 0.f, 0.f, 0.f, 0.f};
                b = __builtin_amdgcn_mfma_f32_32x32x16_bf16(kr[0], qf[0], z16, 0, 0, 0); }
            else b = __builtin_amdgcn_mfma_f32_32x32x16_bf16(kr[d0 % 3], qf[d0], b, 0, 0, 0);
#pragma unroll
            for (int e = 6 + (10 * d0) / KS; e < 6 + (10 * (d0 + 1)) / KS; ++e) {
                const float x = __builtin_amdgcn_exp2f(a[e]);
                a[e] = x;
                rs0 += x;
                if (e == 7)  { pw0.x = pk(a[0], a[1]); pw0.y = pk(a[2], a[3]);   pw0.z = pk(a[4], a[5]);   pw0.w = pk(a[6], a[7]); }
                if (e == 15) { pw1.x = pk(a[8], a[9]); pw1.y = pk(a[10], a[11]); pw1.z = pk(a[12], a[13]); pw1.w = pk(a[14], a[15]); }
            }
            __builtin_amdgcn_sched_barrier(0);
        }
        l_run += rs0;
        float rs_n = 0.f;
#pragma unroll
        for (int kk = 0; kk < 2; ++kk) {
            if (kk == 0) {
#pragma unroll
                for (int d = 0; d < 4; ++d) vf1[d] = *(const LAS bf16x8*)(vb + d * 4608 + 32);
            } else { const LAS unsigned char* ka = lds + kafter_ofs + r32 * KPITCH + hi * 16; kp0 = *(const LAS bf16x8*)(ka); kp1 = *(const LAS bf16x8*)(ka + 32); }
            const bf16x8 pb = __builtin_bit_cast(bf16x8, kk ? pw1 : pw0);
#pragma unroll
            for (int d = 0; d < 4; ++d) {
                o[d] = __builtin_amdgcn_mfma_f32_32x32x16_bf16(kk ? vf1[d] : vf0[d], pb, o[d], 0, 0, 0);
                const int e = 4 * kk + d - 2;
                if (e >= 0) { const float x = __builtin_amdgcn_exp2f(b[e]); b[e] = x; rs_n += x; }
            }
            __builtin_amdgcn_sched_barrier(0);
        }
        rs_early = rs_n;
    };
    int kc = 0, kn = KT_BYTES, kn2 = 2 * KT_BYTES;
    for (int t = 0; t < NT; ++t) {
        const bool has_k2 = (t + 2 < NT), has_v1 = (t + 1 < NT), active = (t <= tmax_w);
        const int vofs = 3 * KT_BYTES + (t & 1) * VT_BYTES;
        if (has_k2) gload_k(t + 2);
        if (has_v1) gload_v(t + 1);
        if (active) substep(sX, sY, kc + 32 * KPITCH, vofs, 0, kn);
        if (active) substep(sY, sX, kn, vofs, 1, kn + 32 * KPITCH);
        if (has_k2) sts_k(kn2);
        if (has_v1) sts_v((t + 1) & 1);
        __syncthreads();
        const int tmp = kc; kc = kn; kn = kn2; kn2 = tmp;
    }
    { auto rr = __builtin_amdgcn_permlane32_swap(__float_as_uint(l_run), __float_as_uint(l_run), false, false); l_run = __uint_as_float(rr[0]) + __uint_as_float(rr[1]); }
    const float inv = 1.f / l_run;
    const int tid_e = fresh_tid(wid0), hi_e = (tid_e >> 5) & 1;
    const size_t rowoff = (size_t)(wid * 32 + (tid_e & 31)) * opitch;
#pragma unroll
    for (int d = 0; d < 4; ++d)
#pragma unroll
        for (int gp = 0; gp < 2; ++gp) {
            const int col = 32 * d + 16 * gp + 8 * hi_e;
            const u32x4 z = *(const u32x4*)(Z + rowoff + col);
            const auto z0 = __builtin_amdgcn_permlane32_swap(z.x, z.z, false, false), z1 = __builtin_amdgcn_permlane32_swap(z.y, z.w, false, false);
            const int g = 2 * gp;
            unsigned a0 = pkv(o[d][4 * g + 0] * inv * bf_lo(z0[0]), o[d][4 * g + 1] * inv * bf_hi(z0[0]));
            unsigned a1 = pkv(o[d][4 * g + 2] * inv * bf_lo(z1[0]), o[d][4 * g + 3] * inv * bf_hi(z1[0]));
            unsigned b0 = pkv(o[d][4 * g + 4] * inv * bf_lo(z0[1]), o[d][4 * g + 5] * inv * bf_hi(z0[1]));
            unsigned b1 = pkv(o[d][4 * g + 6] * inv * bf_lo(z1[1]), o[d][4 * g + 7] * inv * bf_hi(z1[1]));
            const auto w0 = __builtin_amdgcn_permlane32_swap(a0, b0, false, false), w1 = __builtin_amdgcn_permlane32_swap(a1, b1, false, false);
            u32x4 w; w.x = w0[0]; w.y = w1[0]; w.z = w0[1]; w.w = w1[1];
            *(u32x4*)(O + rowoff + col) = w;
        }
}

#define XB_TMO      128
#define XB_XCNT(j)  (256  + 64 * (j))
#define XB_XSUB(j)  (1280 + 64 * (j))
#define XB_XGEN(j)  (2304 + 64 * (j))
#define XB_TOP      3328
#define XB_TOPGEN   3392
#define XCD_BAR_WORDS 3456
#define XB_SPIN_CAP (1u << 18)
__device__ __forceinline__ unsigned xb_ld(unsigned* p)              { return __hip_atomic_load(p, __ATOMIC_RELAXED, __HIP_MEMORY_SCOPE_AGENT); }
__device__ __forceinline__ unsigned xb_add(unsigned* p, unsigned v) { return __hip_atomic_fetch_add(p, v, __ATOMIC_RELAXED, __HIP_MEMORY_SCOPE_AGENT); }
__device__ __forceinline__ unsigned xb_xcc_id() { return (unsigned)__builtin_amdgcn_s_getreg((3 << 11) | 20) & 0xFu; }
#define XB_SPIN(cond, bar) do { unsigned _sp = 0; while (cond) { __builtin_amdgcn_s_sleep(1); \
    if ((++_sp & 255u) == 0u) { if (xb_ld(&(bar)[XB_TMO])) break; if (_sp > XB_SPIN_CAP) { atomicAdd(&(bar)[XB_TMO], 1u); break; } } } } while (0)
__device__ __forceinline__ void xcd_barrier_complete(unsigned* bar, unsigned x, unsigned& nloc, unsigned& nx) {
    const unsigned G = gridDim.x * gridDim.y * gridDim.z;
    unsigned sum, cnt, mine, sp = 0u;
    for (;;) {
        sum = 0u; cnt = 0u; mine = 0u;
#pragma unroll
        for (unsigned j = 0; j < 16; ++j) { const unsigned c = xb_ld(&bar[XB_XCNT(j)]); sum += c; cnt += (c > 0u) ? 1u : 0u; mine = (j == x) ? c : mine; }
        if (sum == G) break;
        __builtin_amdgcn_s_sleep(1);
        if ((++sp & 255u) == 0u) { if (xb_ld(&bar[XB_TMO])) break; if (sp > XB_SPIN_CAP) { atomicAdd(&bar[XB_TMO], 1u); break; } }
    }
    nloc = mine > 0u ? mine : 1u; nx = cnt > 0u ? cnt : 1u;
}
__device__ __forceinline__ void xcd_barrier(unsigned* bar, volatile LAS unsigned* st, const int wid0) {
    asm volatile("s_waitcnt vmcnt(0)" ::: "memory");
    __syncthreads();
    if (fresh_tid(wid0) == 0) {
        const unsigned x = xb_xcc_id();
        __builtin_amdgcn_s_waitcnt(0);
        unsigned nloc = st[0], nx = st[1];
        if (nloc == 0u) { xcd_barrier_complete(bar, x, nloc, nx); st[0] = nloc; st[1] = nx; }
        const unsigned old = xb_add(&bar[XB_XSUB(x)], 1u);
        const unsigned gen = old / nloc;
        if (old + 1u == (gen + 1u) * nloc) {
            __builtin_amdgcn_fence(__ATOMIC_RELEASE, "agent");
            asm volatile("s_waitcnt vmcnt(0)" ::: "memory");
            const unsigned og = xb_add(&bar[XB_TOP], 1u);
            const unsigned tg = og / nx;
            if (og + 1u == (tg + 1u) * nx) xb_add(&bar[XB_TOPGEN], 1u);
            else XB_SPIN(xb_ld(&bar[XB_TOPGEN]) == tg, bar);
            __builtin_amdgcn_fence(__ATOMIC_ACQUIRE, "agent");
            xb_add(&bar[XB_XGEN(x)], 1u);
            asm volatile("s_waitcnt vmcnt(0)" ::: "memory");
        } else {
            XB_SPIN(xb_ld(&bar[XB_XGEN(x)]) == gen, bar);
            __builtin_amdgcn_fence(__ATOMIC_ACQUIRE, "agent");
            asm volatile("s_waitcnt vmcnt(0)" ::: "memory");
        }
    }
    __syncthreads();
}

struct Params { const void* in[22]; float* out; unsigned char* ws; };

__global__ void __launch_bounds__(NTHR, 2) hybrid_fwd(Params P) {
    extern __shared__ __attribute__((aligned(16))) unsigned char lds_raw[];
    LAS unsigned char* lds = (LAS unsigned char*)lds_raw;
    cg::grid_group grid = cg::this_grid();
    const int wid0 = __builtin_amdgcn_readfirstlane((int)threadIdx.x >> 6); const int wid = wid0;
    int tid, lane;
#define FRESH_TID() do { tid = fresh_tid(wid0); lane = tid & 63; } while (0)
    const int G = gridDim.x, bx = blockIdx.x;
    const int vcu = (G % 8 == 0) ? (bx % 8) * (G / 8) + bx / 8 : bx;
    unsigned char* ws = P.ws;
    unsigned* const xbar = (unsigned*)(ws + WS_BAR); volatile LAS unsigned* const xst = (volatile LAS unsigned*)(lds + MISC_OFF);
    if (fresh_tid(wid0) == 0) { xst[0] = 0u; xst[1] = 0u; (void)xb_add(&xbar[XB_XCNT(xb_xcc_id())], 1u); }
    __syncthreads();
#define GRID_BAR() xcd_barrier(xbar, xst, wid0)
    const float* x = (const float*)P.in[0]; const int* positions = (const int*)P.in[1]; const float* mem = (const float*)P.in[2];
#define WT_IN ((bf16_t*)(ws + WS_WT_IN))
#define WT_CONV ((bf16_t*)(ws + WS_WT_CONV))
#define WT_UQ ((bf16_t*)(ws + WS_WT_UQ))
#define WT_UKV ((bf16_t*)(ws + WS_WT_UKV))
#define WT_MLAO ((bf16_t*)(ws + WS_WT_MLAO))
#define WT_MEMKV ((bf16_t*)(ws + WS_WT_MEMKV))
#define WT_MEMO ((bf16_t*)(ws + WS_WT_MEMO))
#define WT_O ((bf16_t*)(ws + WS_WT_O))
#define COS ((float*)(ws + WS_COS))
#define SIN ((float*)(ws + WS_SIN))
#define MEMN ((bf16_t*)(ws + WS_MEMN))
#define MEMKV ((bf16_t*)(ws + WS_MEMKV))
#define VTM ((bf16_t*)(ws + WS_VTM))
#define KR ((float*)(ws + WS_KR))
#define KROPE ((bf16_t*)(ws + WS_KROPE))
#define SSQ ((float*)(ws + WS_SSQ))
#define H ((bf16_t*)(ws + WS_H))
#define CU ((bf16_t*)(ws + WS_CU))
#define BZ ((bf16_t*)(ws + WS_BZ))
#define CQ ((bf16_t*)(ws + WS_CQ))
#define CKV ((bf16_t*)(ws + WS_CKV))
#define VT ((bf16_t*)(ws + WS_VT))
#define MEMQ ((bf16_t*)(ws + WS_MEMQ))
#define MEMZS ((bf16_t*)(ws + WS_MEMZS))
#define MLAZS ((bf16_t*)(ws + WS_MLAZS))
#define GATES ((bf16_t*)(ws + WS_GATES))
#define QRAW ((bf16_t*)(ws + WS_QRAW))
#define MERGED ((bf16_t*)(ws + WS_MERGED))
#define CONVA ((bf16_t*)(ws + WS_CONVA))
#define MEMY ((bf16_t*)(ws + WS_MEMY))
#ifdef DUP_P0
    for (int rep = 0; rep < 2; ++rep)
#endif
    {
        auto item_desc = [&](int it, const float*& W, int& Nsrc, int& K, int& ns0, int& nd0, int& k0, bf16_t*& Wt, const float*& gk) __attribute__((always_inline)) {
            int r = it; gk = nullptr;
            if (r < 3904) { W = (const float*)P.in[4]; Nsrc = NIN_SRC; K = 2048; Wt = WT_IN; const int kt = r & 15, nt = r >> 4; k0 = kt * 128; nd0 = nt * 64;
                if (nd0 < 4096) ns0 = ((nd0 & 255) >> 6) * 1024 + (nd0 >> 8) * 64;
                else if (nd0 < 5120) ns0 = nd0;
                else if (nd0 < 5376) ns0 = (nd0 == 5120) ? 5120 : -1;
                else ns0 = nd0 - 192;
            } else { r -= 3904; int nkt;
                if (r < 256)                 { W = (const float*)P.in[6];  Nsrc = 2048; K = 1024; Wt = WT_CONV;  nkt = 8; }
                else if ((r -= 256) < 192)   { W = (const float*)P.in[8];  Nsrc = 3072; K = 512;  Wt = WT_UQ;    nkt = 4; gk = (const float*)P.in[7]; }
                else if ((r -= 192) < 256)   { W = (const float*)P.in[10]; Nsrc = 4096; K = 512;  Wt = WT_UKV;   nkt = 4; gk = (const float*)P.in[9]; }
                else if ((r -= 256) < 512)   { W = (const float*)P.in[15]; Nsrc = 2048; K = 2048; Wt = WT_MLAO;  nkt = 16; }
                else if ((r -= 512) < 512)   { W = (const float*)P.in[17]; Nsrc = 2048; K = 2048; Wt = WT_MEMKV; nkt = 16; }
                else if ((r -= 512) < 256)   { W = (const float*)P.in[20]; Nsrc = 2048; K = 1024; Wt = WT_MEMO;  nkt = 8; }
                else { r -= 256;               W = (const float*)P.in[21]; Nsrc = 2048; K = 2048; Wt = WT_O;     nkt = 16; }
                k0 = (r % nkt) * 128; nd0 = (r / nkt) * 64; ns0 = nd0;
            }
        };
        for (int it0 = bx; it0 < 6400; it0 += 4 * G) {
            FRESH_TID();
            f32x4 v[4][4];
#pragma unroll
            for (int j = 0; j < 4; ++j) { const int it = it0 + j * G;
                if (it < 6400) { const float* W; int Nsrc, K, ns0, nd0, k0; bf16_t* Wt; const float* gk; item_desc(it, W, Nsrc, K, ns0, nd0, k0, Wt, gk);
                    if (ns0 >= 0) {
#pragma unroll
                        for (int p = 0; p < 4; ++p) { const int kk = p * 32 + (tid >> 4), n4 = (tid & 15) * 4;
                            v[j][p] = *(const f32x4*)(W + (size_t)(k0 + kk) * Nsrc + ns0 + n4);
                            if (gk) v[j][p] = v[j][p] * gk[k0 + kk]; } } } }
#pragma unroll
            for (int j = 0; j < 4; ++j) { const int it = it0 + j * G;
                if (it < 6400) { const float* W; int Nsrc, K, ns0, nd0, k0; bf16_t* Wt; const float* gk; item_desc(it, W, Nsrc, K, ns0, nd0, k0, Wt, gk);
                    if (ns0 >= 0) { LAS bf16_t* T = (LAS bf16_t*)lds + j * (64 * 136);
#pragma unroll
                        for (int p = 0; p < 4; ++p) { const int kk = p * 32 + (tid >> 4), n4 = (tid & 15) * 4;
                            const unsigned a = pk(v[j][p][0], v[j][p][1]), c = pk(v[j][p][2], v[j][p][3]);
                            T[(n4 + 0) * 136 + kk] = (bf16_t)(a & 0xffffu); T[(n4 + 1) * 136 + kk] = (bf16_t)(a >> 16);
                            T[(n4 + 2) * 136 + kk] = (bf16_t)(c & 0xffffu); T[(n4 + 3) * 136 + kk] = (bf16_t)(c >> 16); } } } }
            __syncthreads();
#pragma unroll
            for (int j = 0; j < 4; ++j) { const int it = it0 + j * G;
                if (it < 6400) { const float* W; int Nsrc, K, ns0, nd0, k0; bf16_t* Wt; const float* gk; item_desc(it, W, Nsrc, K, ns0, nd0, k0, Wt, gk);
                    const LAS bf16_t* T = (const LAS bf16_t*)lds + j * (64 * 136);
#pragma unroll
                    for (int p = 0; p < 2; ++p) { const int n = p * 32 + (tid >> 4), c = tid & 15;
                        u32x4 o = (u32x4){0u, 0u, 0u, 0u};
                        if (ns0 >= 0) o = *(const LAS u32x4*)(T + n * 136 + c * 8);
                        *(u32x4*)(Wt + (size_t)(nd0 + n) * K + k0 + c * 8) = o; } } }
            __syncthreads();
        }
        FRESH_TID();
        const int gw = bx * 8 + wid, NGW = G * 8;
        for (int m = gw; m < NBATCH * TB; m += 2 * NGW) {
            if (m + NGW < NBATCH * TB) rms_row2(x + (size_t)m * DM, x + (size_t)(m + NGW) * DM, (const float*)P.in[3], H + (size_t)m * DM, H + (size_t)(m + NGW) * DM, lane);
            else rms_row(x + (size_t)m * DM, (const float*)P.in[3], H + (size_t)m * DM, lane); }
        for (int m = gw; m < 512; m += NGW) rms_row(mem + (size_t)m * DM, (const float*)P.in[16], MEMN + (size_t)m * DM, lane);
        for (int e = bx * NTHR + tid; e < NBATCH * TB * 32; e += G * NTHR) {
            const int tok = e >> 5, i = e & 31; const double rev = (double)positions[tok] * kInvFreqRev[i]; const float f = (float)(rev - rint(rev));
            COS[e] = __builtin_amdgcn_cosf(f); SIN[e] = __builtin_amdgcn_sinf(f);
        }
    }
    if (P.ws == nullptr) grid.sync();
    GRID_BAR();

    for (int b = 0; b < NBATCH; ++b) {
        bf16_t* KN = (bf16_t*)(P.out + (size_t)b * TB * DM);
        bf16_t* MLAY = KN + (size_t)TB * 2048;
        {
            pg8::Gemm g{H + (size_t)b * TB * DM, WT_IN, TB, NIN, DM}; pg8::StaticOrder S; S.init(TB, NIN, G, bx);
            Epi1 E{CU, BZ, CQ, CKV, MLAZS, MEMQ, MEMZS, GATES, KR, SSQ};
#ifdef DUP_P1
#pragma nounroll
            for (int rep = 0; rep < 2; ++rep)
#endif
            pg8::gemm_phase<Epi1, pg8::StaticOrder, true, true>(lds, g, S, E, wid0);
            if (b == 0) {
                pg8::Gemm g2{MEMN, WT_MEMKV, 512, 2048, DM}; pg8::StaticOrder S2; S2.init(512, 2048, G, (bx + G - ((TB / 256) * (NIN / 256)) % G) % G);
                EpiRowScale E2{MEMKV, 2048, nullptr, 0.f};
                pg8::gemm_phase<EpiRowScale, pg8::StaticOrder, true, true>(lds, g2, S2, E2, wid0);
            }
        }
        GRID_BAR();
        {
            FRESH_TID();
            { pg8::Gemm g{CQ, WT_UQ, TB, 3072, 512, CKV, WT_UKV}; pg8::DualOrder S; S.a.init(TB, 3072, G, bx); S.b.init(TB, 4096, G, bx);
              EpiQKV E{EpiRowScale{QRAW, 3072, SSQ, 1.f / 512.f}, EpiKV{KN, VT, SSQ + (size_t)TB * 8, (const float*)P.in[13], (LAS float*)(lds + XCH_OFF)}};
              pg8::gemm_phase<EpiQKV, pg8::DualOrder, true, true>(lds, g, S, E, wid0); }
            const float* cw = (const float*)P.in[5];
            const int cv_lo = (G == 256) ? (bx < 128 ? bx * 4 : 512 + (bx - 128) * 12) : bx, cv_n = (G == 256) ? (bx < 128 ? 4 : 12) : (TB / 4 - bx + G - 1) / G, cv_st = (G == 256) ? 1 : G;
            for (int ii = 0; ii < cv_n; ++ii) { const int it = cv_lo + ii * cv_st;
                const int t = it * 4 + (tid >> 7), c8 = (tid & 127) * 8;
                const u32x4 zero = (u32x4){0u, 0u, 0u, 0u};
                const u32x4 a2 = *(const u32x4*)(CU + (size_t)t * 1024 + c8);
                const u32x4 a1 = (t >= 1) ? *(const u32x4*)(CU + (size_t)(t - 1) * 1024 + c8) : zero;
                const u32x4 a0 = (t >= 2) ? *(const u32x4*)(CU + (size_t)(t - 2) * 1024 + c8) : zero;
                const u32x4 bb = *(const u32x4*)(BZ + (size_t)t * 1024 + c8);
                float w0[8], w1[8], w2[8];
#pragma unroll
                for (int e = 0; e < 8; ++e) { w0[e] = cw[c8 + e]; w1[e] = cw[1024 + c8 + e]; w2[e] = cw[2048 + c8 + e]; }
                u32x4 o;
#pragma unroll
                for (int e = 0; e < 4; ++e) {
                    const float lo = bf_lo(bb[e]) * (w0[2 * e] * bf_lo(a0[e]) + w1[2 * e] * bf_lo(a1[e]) + w2[2 * e] * bf_lo(a2[e]));
                    const float hh = bf_hi(bb[e]) * (w0[2 * e + 1] * bf_hi(a0[e]) + w1[2 * e + 1] * bf_hi(a1[e]) + w2[2 * e + 1] * bf_hi(a2[e]));
                    o[e] = pk(lo, hh); }
                *(u32x4*)(CONVA + (size_t)t * 1024 + c8) = o;
            }
            const int bxr = (G == 256) ? (bx + 128) % 256 : bx;
            for (int ps = bxr; ps < TB / 64; ps += G) {
                const int t = ps * 64 + (tid >> 3), sub = tid & 7; const float* gk = (const float*)P.in[14];
                const f32x4 xa = *(const f32x4*)(KR + (size_t)t * 64 + sub * 8), xb = *(const f32x4*)(KR + (size_t)t * 64 + sub * 8 + 4);
                float s = (xa[0] * xa[0] + xa[1] * xa[1]) + (xa[2] * xa[2] + xa[3] * xa[3]) + (xb[0] * xb[0] + xb[1] * xb[1]) + (xb[2] * xb[2] + xb[3] * xb[3]);
                s += shx(s, 1, lane); s += shx(s, 2, lane); s += shx(s, 4, lane);
                const float rs = __builtin_amdgcn_rsqf(s * (1.f / 64.f) + EPS);
                float y[8];
#pragma unroll
                for (int e = 0; e < 8; ++e) {
                    const float xn = ((e < 4) ? xa[e & 3] : xb[e & 3]) * rs * gk[sub * 8 + e];
                    const float pr = shx(xn, 4, lane);
                    const int i = (sub & 3) * 8 + e; const float c = COS[(size_t)(b * TB + t) * 32 + i], sn = SIN[(size_t)(b * TB + t) * 32 + i];
                    y[e] = (sub < 4) ? (xn * c - pr * sn) : (xn * c + pr * sn); }
                u32x4 o; o.x = pk(y[0], y[1]); o.y = pk(y[2], y[3]); o.z = pk(y[4], y[5]); o.w = pk(y[6], y[7]);
                *(u32x4*)(KROPE + (size_t)t * 64 + sub * 8) = o;
            }
            if (b == 0) {
                for (int ps = bxr; ps < 64; ps += G) { const int pi = ps * 32 + (tid >> 4), m = pi >> 2, h = pi & 3;
                    norm_row16<256>(MEMKV + (size_t)m * 2048 + h * 256, (const float*)P.in[19], tid & 15, lane); }
                for (int it = (G == 256) ? (bx + 64) % 256 : bx; it < 64; it += G) { const int kt = it & 3, half = (it >> 2) & 1, h = (it >> 3) & 3, bb = it >> 5;
                    vt_item(lds, MEMKV + (size_t)(bb * 256 + kt * 64) * 2048 + 1024 + h * 256 + half * 128, 2048, VTM + (size_t)it * 9216, wid0); }
            }
        }
        GRID_BAR();
        {
#ifdef DUP_ATTN
            for (int rep = 0; rep < 2; ++rep)
#endif
            for (int u = vcu; u < 256; u += G) { const int h = u >> 4, s = u & 15;
#pragma unroll 1
                for (int k = 0; k < 2; ++k) { const int qb = k ? s : 31 - s;
                    attn_unit2<192, true>(lds, QRAW + (size_t)(qb * 256) * 3072 + h * 192, 3072, (const float*)P.in[11], (const float*)P.in[12],
                                         COS + (size_t)(b * TB + qb * 256) * 32, SIN + (size_t)(b * TB + qb * 256) * 32, 0.07216878364870323f * LOG2E,
                                         KN + h * 128, 2048, KROPE, VT + (size_t)(h * 128) * 9216, 4 * qb + 4, 4 * qb,
                                         MLAZS + (size_t)(qb * 256) * 2048 + h * 128, MLAY + (size_t)(qb * 256) * 2048 + h * 128, 2048, wid0); }
            }
            for (int u = bx; u < 256; u += G) { const int half = u & 1, h = (u >> 1) & 3, qb = u >> 3;
                attn_unit<256, false>(lds, MEMQ + (size_t)(qb * 256) * 1024 + h * 256, 1024, (const float*)P.in[18], nullptr, nullptr, nullptr, 0.0625f * LOG2E,
                                      MEMKV + (size_t)(b * 256) * 2048 + h * 256, 2048, nullptr, VTM + (size_t)(((b * 4 + h) * 2 + half) * 4) * 9216, 4, 3,
                                      MEMZS + (size_t)(qb * 256) * 1024 + h * 256 + half * 128, MEMY + (size_t)(qb * 256) * 1024 + h * 256 + half * 128, 1024, wid0); }
        }
        GRID_BAR();
        {
            pg8::StaticOrder S; S.init(TB, 2048, G, bx);
            { pg8::Gemm g{CONVA, WT_CONV, TB, 2048, 1024, MEMY, WT_MEMO}; pg8::DualOrder S2; S2.a = S; S2.b = S;
              EpiGate2 E{EpiGate{GATES, MERGED, 1}, EpiGate{GATES + (size_t)2 * TB * 2048, MERGED, 0}};
              pg8::gemm_phase<EpiGate2, pg8::DualOrder, true, true>(lds, g, S2, E, wid0); }
            { pg8::Gemm g{MLAY, WT_MLAO, TB, 2048, 2048}; EpiGate E{GATES + (size_t)TB * 2048, MERGED, 0};
              pg8::gemm_phase<EpiGate, pg8::StaticOrder, true, true>(lds, g, S, E, wid0); }
        }
        GRID_BAR();
        {
            pg8::Gemm g{MERGED, WT_O, TB, 2048, 2048}; pg8::StaticOrder S; S.init(TB, 2048, G, bx);
            EpiOut E{x + (size_t)b * TB * DM, P.out + (size_t)b * TB * DM};
            pg8::gemm_phase<EpiOut, pg8::StaticOrder, true, true>(lds, g, S, E, wid0);
        }
    }
}

extern "C" void kernel_launch(void* const* d_in, const int* in_sizes, int n_in, void* d_out, int out_size, void* d_ws, size_t ws_size, hipStream_t stream) {
    static int grid_blocks = 0;
    if (grid_blocks == 0) {
        if (n_in != 22 || ws_size < WS_END) { fprintf(stderr, "kernel_launch: unexpected n_in %d / ws_size %zu\n", n_in, ws_size); grid_blocks = -1; return; }
        int dev = 0, cus = 0, per_cu = 0;
        hipGetDevice(&dev);
        hipDeviceGetAttribute(&cus, hipDeviceAttributeMultiprocessorCount, dev);
        hipFuncSetAttribute((const void*)hybrid_fwd, hipFuncAttributeMaxDynamicSharedMemorySize, LDS_BYTES);
        hipOccupancyMaxActiveBlocksPerMultiprocessor(&per_cu, (const void*)hybrid_fwd, NTHR, LDS_BYTES);
        if (per_cu < 1) per_cu = 1;
        grid_blocks = cus * per_cu;
        (void)hipGetLastError();
    }
    if (grid_blocks < 0) return;
    if (hipMemsetAsync((char*)d_ws + WS_BAR, 0, 16384, stream) != hipSuccess) { fprintf(stderr, "kernel_launch: memset of barrier words failed\n"); return; }
    Params p{};
    for (int i = 0; i < 22; ++i) p.in[i] = d_in[i];
    p.out = (float*)d_out; p.ws = (unsigned char*)d_ws;
    void* args[] = {&p};
    hipError_t e = hipLaunchCooperativeKernel((const void*)hybrid_fwd, dim3(grid_blocks), dim3(NTHR), args, LDS_BYTES, stream);
    if (e != hipSuccess) fprintf(stderr, "cooperative launch failed: %s (grid %d)\n", hipGetErrorString(e), grid_blocks);
}
```
